# Optimizing an MI355X kernel written in HIP

```python
import math
import jax, jax.numpy as jnp
from jax import lax
import numpy as np


D_MODEL = 1024
BATCH = 16
SEQ = 4096
DEPTH = 2
DEC_BATCH = 2
DEC_SEQ = 8192
PAST_LEN = 128

RMS_EPS = 1e-6
ROPE_THETA = 10000.0
NEG_INF = -1e30

POOL_WIDTH = 512
POOL_WINDOWS = (2, 4, 8, 16)
POOL_GROUPS = len(POOL_WINDOWS)
POOL_GW = POOL_WIDTH // POOL_GROUPS

MLA_HEADS = 8
MLA_NOPE = 64
MLA_ROPE = 32
MLA_V = 64
MLA_QK = MLA_NOPE + MLA_ROPE
MLA_Q_RANK = 384
MLA_KV_RANK = 256
MLA_QBLOCK = 128

DIL_PAIRS = ((128, 1), (512, 4), (2048, 16))
DIL_GROUPS = len(DIL_PAIRS)
DIL_HEADS = 4
DIL_HEAD_DIM = 128
DIL_QKV = DIL_GROUPS * DIL_HEADS * DIL_HEAD_DIM
DIL_BLOCK = 64

N_BRANCH = 3
BRANCH_A = POOL_WIDTH
BRANCH_B = MLA_HEADS * MLA_V
BRANCH_C = DIL_HEADS * DIL_HEAD_DIM
D_FF = 4 * D_MODEL

IN_SPLITS = (POOL_WIDTH, MLA_Q_RANK, MLA_KV_RANK, MLA_ROPE, DIL_QKV, DIL_QKV, DIL_QKV, N_BRANCH * D_MODEL)
IN_WIDTH = sum(IN_SPLITS)
IN_OFFSETS = [int(o) for o in np.cumsum(IN_SPLITS)[:-1]]

kernel_name = "hybrid_pool_mla_dilated_encoder"


def rms_norm(x, g):
    xf = x.astype(jnp.float32)
    y = xf * lax.rsqrt(jnp.mean(xf * xf, axis=-1, keepdims=True) + RMS_EPS)
    return (y * g.astype(jnp.float32)).astype(x.dtype)


def rope(x, pos):
    half = x.shape[-1] // 2
    inv = ROPE_THETA ** (-jnp.arange(half, dtype=jnp.float32) / half)
    ang = pos.astype(jnp.float32)[:, None] * inv[None, :]
    cos = jnp.cos(ang)[:, None, :].astype(x.dtype)
    sin = jnp.sin(ang)[:, None, :].astype(x.dtype)
    x1, x2 = x[..., :half], x[..., half:]
    return jnp.concatenate([x1 * cos - x2 * sin, x2 * cos + x1 * sin], axis=-1)


def pool_mixer(u, w_grp, scale):
    B, S, _ = u.shape
    uf = u.reshape(B, S, POOL_GROUPS, POOL_GW).astype(jnp.float32)
    csum = jnp.concatenate([jnp.zeros((B, 1, POOL_GROUPS, POOL_GW), jnp.float32), jnp.cumsum(uf, axis=1)], axis=1)
    t = jnp.arange(S)
    means = []
    for g, w in enumerate(POOL_WINDOWS):
        lo = jnp.clip(t - w // 2, 0, S)
        hi = jnp.clip(t + w // 2, 0, S)
        cnt = (hi - lo).astype(jnp.float32)
        means.append((csum[:, hi, g] - csum[:, lo, g]) / cnt[None, :, None])
    mixed = (jnp.stack(means, axis=2) - uf).astype(u.dtype)
    y = jnp.einsum('bsgc,gcd->bsgd', mixed, w_grp)
    return y.reshape(B, S, POOL_WIDTH) * scale


def mla_mixer(cq, ckv, kr, q_norm, kv_norm, w_uq, w_uk, w_uv, pos):
    B, S, _ = cq.shape
    q = jnp.einsum('bsr,rn->bsn', rms_norm(cq, q_norm), w_uq).reshape(B, S, MLA_HEADS, MLA_QK)
    q = jnp.concatenate([q[..., :MLA_NOPE], rope(q[..., MLA_NOPE:], pos)], axis=-1)
    c = rms_norm(ckv, kv_norm)
    k_nope = jnp.einsum('bsr,rn->bsn', c, w_uk).reshape(B, S, MLA_HEADS, MLA_NOPE)
    v = jnp.einsum('bsr,rn->bsn', c, w_uv).reshape(B, S, MLA_HEADS, MLA_V)
    k_rope = rope(kr[:, :, None, :], pos)
    k = jnp.concatenate([k_nope, jnp.broadcast_to(k_rope, (B, S, MLA_HEADS, MLA_ROPE))], axis=-1)
    scale = MLA_QK ** -0.5
    nq = S // MLA_QBLOCK
    qb = q.reshape(B, nq, MLA_QBLOCK, MLA_HEADS, MLA_QK).transpose(1, 0, 2, 3, 4)

    def attend(qblk):
        s = jnp.einsum('bqhd,bkhd->bhqk', qblk, k).astype(jnp.float32) * scale
        p = jax.nn.softmax(s, axis=-1).astype(v.dtype)
        return jnp.einsum('bhqk,bkhd->bqhd', p, v)

    o = lax.map(attend, qb)
    return o.transpose(1, 0, 2, 3, 4).reshape(B, S, MLA_HEADS * MLA_V)


def dilated_group(q, k, v, half_w, d):
    B, S, H, dh = q.shape
    L = S // d
    nb = -(-L // DIL_BLOCK)
    Lp = nb * DIL_BLOCK

    def by_residue(x):
        x = x.reshape(B, L, d, H, dh).transpose(0, 2, 1, 3, 4)
        return jnp.pad(x, ((0, 0), (0, 0), (0, Lp - L), (0, 0), (0, 0)))

    def neighbours(x):
        xb = x.reshape(B, d, nb, DIL_BLOCK, H, dh)
        xp = jnp.pad(xb, ((0, 0), (0, 0), (1, 1), (0, 0), (0, 0), (0, 0)))
        return jnp.concatenate([xp[:, :, :-2], xp[:, :, 1:-1], xp[:, :, 2:]], axis=3)

    qb = by_residue(q).reshape(B, d, nb, DIL_BLOCK, H, dh)
    kb = neighbours(by_residue(k))
    vb = neighbours(by_residue(v))
    qpos = jnp.arange(nb)[:, None] * DIL_BLOCK + jnp.arange(DIL_BLOCK)[None, :]
    kpos = (jnp.arange(nb)[:, None] - 1) * DIL_BLOCK + jnp.arange(3 * DIL_BLOCK)[None, :]
    valid = (jnp.abs(qpos[:, :, None] - kpos[:, None, :]) <= half_w) & (kpos[:, None, :] >= 0) & (kpos[:, None, :] < L)
    s = jnp.einsum('brnqhd,brnkhd->brnhqk', qb, kb).astype(jnp.float32) * (dh ** -0.5)
    s = jnp.where(valid[None, None, :, None], s, NEG_INF)
    lse = jax.nn.logsumexp(s, axis=-1)
    p = jnp.exp(s - lse[..., None]).astype(v.dtype)
    o = jnp.einsum('brnhqk,brnkhd->brnqhd', p, vb)
    o = o.reshape(B, d, Lp, H, dh)[:, :, :L].transpose(0, 2, 1, 3, 4).reshape(B, S, H, dh)
    lse = lse.transpose(0, 1, 2, 4, 3).reshape(B, d, Lp, H)[:, :, :L].transpose(0, 2, 1, 3).reshape(B, S, H)
    return o, lse


def dilated_mixer(qd, kd, vd, pos):
    B, S, _ = qd.shape
    shp = (B, S, DIL_GROUPS * DIL_HEADS, DIL_HEAD_DIM)
    q = rope(qd.reshape(shp), pos).reshape(B, S, DIL_GROUPS, DIL_HEADS, DIL_HEAD_DIM)
    k = rope(kd.reshape(shp), pos).reshape(B, S, DIL_GROUPS, DIL_HEADS, DIL_HEAD_DIM)
    v = vd.reshape(B, S, DIL_GROUPS, DIL_HEADS, DIL_HEAD_DIM)
    outs, lses = [], []
    for g, (w, d) in enumerate(DIL_PAIRS):
        o, l = dilated_group(q[:, :, g], k[:, :, g], v[:, :, g], w // (2 * d), d)
        outs.append(o)
        lses.append(l)
    alpha = jax.nn.softmax(jnp.stack(lses, axis=0), axis=0).astype(v.dtype)
    o = jnp.einsum('gbsh,gbshd->bshd', alpha, jnp.stack(outs, axis=0))
    return o.reshape(B, S, BRANCH_C)


def encoder_layer(x, ln1, w_in, pool_w, pool_scale, q_norm, kv_norm, w_uq, w_uk, w_uv,
                  w_a, w_b, w_c, w_o, ln2, w_ff1, w_ff2):
    B, S, D = x.shape
    pos = jnp.arange(S)
    h = rms_norm(x, ln1)
    z = jnp.einsum('bsd,dn->bsn', h, w_in)
    u_pool, cq, ckv, kr, qd, kd, vd, gate_logits = jnp.split(z, IN_OFFSETS, axis=-1)
    a = pool_mixer(u_pool, pool_w, pool_scale)
    b = mla_mixer(cq, ckv, kr, q_norm, kv_norm, w_uq, w_uk, w_uv, pos)
    c = dilated_mixer(qd, kd, vd, pos)
    gates = jax.nn.sigmoid(gate_logits.astype(jnp.float32)).astype(x.dtype).reshape(B, S, N_BRANCH, D)
    merged = (gates[:, :, 0] * jnp.einsum('bsc,cd->bsd', a, w_a)
              + gates[:, :, 1] * jnp.einsum('bsc,cd->bsd', b, w_b)
              + gates[:, :, 2] * jnp.einsum('bsc,cd->bsd', c, w_c))
    x = x + jnp.einsum('bsd,de->bse', merged, w_o)
    h2 = rms_norm(x, ln2)
    ff = jnp.square(jax.nn.relu(jnp.einsum('bsd,df->bsf', h2, w_ff1)))
    return x + jnp.einsum('bsf,fd->bsd', ff, w_ff2)


def setup_inputs(seed: int = 0) -> dict:
    key = jax.random.key(seed)
    ks = jax.random.split(key, 24)

    def w(k, shape, fan_in):
        return jax.random.normal(k, shape, jnp.float32) * (fan_in ** -0.5)

    def gain(k, shape):
        return 1.0 + 0.02 * jax.random.normal(k, shape, jnp.float32)

    return {
        'x_prompt': jax.random.normal(ks[0], (BATCH, SEQ, D_MODEL), jnp.float32),
        'x_sample': jax.random.normal(ks[1], (DEC_BATCH, DEC_SEQ, D_MODEL), jnp.float32),
        'ln1': gain(ks[2], (DEPTH, D_MODEL)),
        'w_in': w(ks[3], (DEPTH, D_MODEL, IN_WIDTH), D_MODEL),
        'pool_w': w(ks[4], (DEPTH, POOL_GROUPS, POOL_GW, POOL_GW), POOL_GW),
        'pool_scale': gain(ks[5], (DEPTH, POOL_WIDTH)),
        'q_norm': gain(ks[6], (DEPTH, MLA_Q_RANK)),
        'kv_norm': gain(ks[7], (DEPTH, MLA_KV_RANK)),
        'w_uq': w(ks[8], (DEPTH, MLA_Q_RANK, MLA_HEADS * MLA_QK), MLA_Q_RANK),
        'w_uk': w(ks[9], (DEPTH, MLA_KV_RANK, MLA_HEADS * MLA_NOPE), MLA_KV_RANK),
        'w_uv': w(ks[10], (DEPTH, MLA_KV_RANK, MLA_HEADS * MLA_V), MLA_KV_RANK),
        'w_a': w(ks[11], (DEPTH, BRANCH_A, D_MODEL), BRANCH_A),
        'w_b': w(ks[12], (DEPTH, BRANCH_B, D_MODEL), BRANCH_B),
        'w_c': w(ks[13], (DEPTH, BRANCH_C, D_MODEL), BRANCH_C),
        'w_o': w(ks[14], (DEPTH, D_MODEL, D_MODEL), D_MODEL),
        'ln2': gain(ks[15], (DEPTH, D_MODEL)),
        'w_ff1': w(ks[16], (DEPTH, D_MODEL, D_FF), D_MODEL),
        'w_ff2': w(ks[17], (DEPTH, D_FF, D_MODEL), D_FF),
        'final_norm': gain(ks[18], (D_MODEL,)),
    }


def reference(x_prompt, x_sample, ln1, w_in, pool_w, pool_scale, q_norm, kv_norm, w_uq, w_uk, w_uv,
              w_a, w_b, w_c, w_o, ln2, w_ff1, w_ff2, final_norm):
    hp, hs = x_prompt, x_sample
    for l in range(DEPTH):
        params = (ln1[l], w_in[l], pool_w[l], pool_scale[l], q_norm[l], kv_norm[l], w_uq[l], w_uk[l], w_uv[l],
                  w_a[l], w_b[l], w_c[l], w_o[l], ln2[l], w_ff1[l], w_ff2[l])
        hp = encoder_layer(hp, *params)
        hs = encoder_layer(hs, *params)
    y_prompt = rms_norm(hp, final_norm)
    y_sample = rms_norm(hs, final_norm)
    return (y_prompt, y_sample)
```

```cpp
#include <hip/hip_runtime.h>
#include <hip/hip_cooperative_groups.h>
#include <cstdio>
#include <cstdint>
namespace cg = cooperative_groups;

#ifndef COOP
#define COOP 1
#endif
#ifndef PROBE
#define PROBE 0
#endif
#ifndef STAGGER
#define STAGGER 0
#endif
#ifndef WGM_IN
#define WGM_IN 4
#endif
#ifndef WGM_FF
#define WGM_FF 4
#endif

constexpr int DM = 1024, TCH = 16384, NCHUNK = 5, NLAYER = 2, INW = 8864, INP = 8960, DFF = 4096;
constexpr float RMS_EPS = 1e-6f;
constexpr float QSC_MLA = 0.14724444602590306f;
constexpr float QSC_DIL = 0.12751743082459868f;
constexpr size_t MiB = (size_t)1 << 20;
constexpr size_t W_IN = 0, W_FF1 = W_IN + (size_t)INP * 1024 * 2, W_FF2 = W_FF1 + (size_t)4096 * 1024 * 2, W_O = W_FF2 + (size_t)4096 * 1024 * 2, W_A = W_O + (size_t)1024 * 1024 * 2,
                 W_B = W_A + (size_t)1024 * 512 * 2, W_C = W_B + (size_t)1024 * 512 * 2, W_UQ = W_C + (size_t)1024 * 512 * 2, W_UK = W_UQ + (size_t)768 * 384 * 2, W_UV = W_UK + (size_t)512 * 256 * 2,
                 W_LAYER = W_UV + (size_t)512 * 256 * 2;
static_assert(2 * W_LAYER <= 80 * MiB, "weights");
constexpr size_t WS_CS128 = 80 * MiB, WS_CS32 = 84 * MiB, WS_H = 86 * MiB, WS_UP = 118 * MiB, WS_CQ = 134 * MiB, WS_QD = 158 * MiB, WS_KD = 206 * MiB, WS_VDT = 254 * MiB,
                 WS_GATES = 302 * MiB, WS_MIX = 398 * MiB, WS_Q = 414 * MiB, WS_K = 438 * MiB, WS_VT = 462 * MiB, WS_OG = 478 * MiB, WS_LSE = 526 * MiB, WS_CB = 527 * MiB,
                 WS_BB = 543 * MiB, WS_TMP = 559 * MiB, WS_MRG = 623 * MiB, WS_FF = 655 * MiB, WS_BAR = 783 * MiB, WS_BR = 784 * MiB, WS_STAT = 832 * MiB, WS_END = 833 * MiB;

typedef float f32x16 __attribute__((ext_vector_type(16)));
typedef float f32x2_t __attribute__((ext_vector_type(2)));
typedef __bf16 bf16x2_t __attribute__((ext_vector_type(2)));
typedef short s16x4 __attribute__((ext_vector_type(4)));
typedef unsigned u32x2 __attribute__((ext_vector_type(2)));
#define DI __device__ __forceinline__
typedef unsigned long long sq_t;
#define LASQ __attribute__((address_space(3)))

DI unsigned cvtpk(float lo, float hi) { f32x2_t v = {lo, hi}; bf16x2_t b = __builtin_convertvector(v, bf16x2_t); return __builtin_bit_cast(unsigned, b); }
DI unsigned short f2bf(float f) { return (unsigned short)(cvtpk(f, 0.f) & 0xffffu); }
DI float bflo(unsigned u) { return __builtin_bit_cast(float, u << 16); }
DI float bfhi(unsigned u) { return __builtin_bit_cast(float, u & 0xffff0000u); }
DI float fexp2(float x) { return __builtin_amdgcn_exp2f(x); }
DI float shx(float v, int lane, int mask) { return __builtin_bit_cast(float, __builtin_amdgcn_ds_bpermute((lane ^ mask) << 2, __builtin_bit_cast(int, v))); }
DI float wave_sum(float v, int lane) {
#pragma unroll
    for (int o = 1; o < 64; o <<= 1) v += shx(v, lane, o);
    return v;
}
DI int fresh_lane() { int l; asm volatile("v_mbcnt_lo_u32_b32 %0, -1, 0\n\tv_mbcnt_hi_u32_b32 %0, -1, %0" : "=v"(l)); return l; }
namespace pg8 {
#define PG8_LAS __attribute__((address_space(3)))
typedef unsigned short bf16_t;
typedef short bf16x8 __attribute__((ext_vector_type(8)));
typedef float f32x4 __attribute__((ext_vector_type(4)));
typedef unsigned u32x4 __attribute__((ext_vector_type(4)));
constexpr int BM = 256, BK = 64, HALF = 128, HTB = HALF * BK * 2  , STAGE_BYTES = 8 * HTB, NXCD = 8, WGM = 4;

__host__ __device__ __forceinline__ int lds_byte(int r, int c) { const int st = (r >> 4) * 2 + (c >> 5), rr = r & 15, cc = c & 31, ob = rr * 64 + cc * 2; return st * 1024 + (ob ^ (((ob >> 9) & 1) << 5)); }
__host__ __device__ __forceinline__ void stage_rc(int b, int& R, int& C) { const int st = b / 1024, sb = b % 1024, swz = sb ^ (((sb >> 9) & 1) << 5); R = (st >> 1) * 16 + swz / 64; C = (st & 1) * 32 + (swz % 64) / 2; }
__host__ __device__ __forceinline__ int perm32(int rho) { const int n = rho >> 4, i = rho & 15; return 8 * (i >> 2) + 4 * n + (i & 3); }

struct Unit { int pm, pn; };
struct Gemm { const bf16_t* A; const bf16_t* Bt; int M, N, K, lda; };

struct StaticOrder {
    int nM, nN, nwg, G, c, wgm;
    __host__ __device__ void init(int M, int N, int G_, int c_, int wgm_ = WGM) { nM = M / BM; nN = N / BM; nwg = nM * nN; G = G_; c = c_; wgm = wgm_; }
    __host__ __device__ bool next(int i, Unit& u) const {
        const long L = (long)i * G + c; if (L >= nwg) return false;
        int wgid = (int)L; { const int q = nwg / NXCD, r = nwg % NXCD, xcd = wgid % NXCD, off = wgid / NXCD; wgid = (xcd < r ? xcd * (q + 1) : r * (q + 1) + (xcd - r) * q) + off; }
        const int nig = wgm * nN, gid = wgid / nig, fm = gid * wgm, gsz = (nM - fm) < wgm ? (nM - fm) : wgm;
        u.pm = fm + ((wgid % nig) % gsz); u.pn = (wgid % nig) / gsz; return true;
    }
    __device__ __forceinline__ void a_ready(const Unit&) const {}
    __device__ __forceinline__ void done(const Unit&) const {}
};

enum { EM_INPROJ = 0, EM_Q, EM_K, EM_V, EM_MRG, EM_WO, EM_FF1, EM_FF2 };
typedef unsigned u32x2e __attribute__((ext_vector_type(2)));
template <int mode> struct EpiAll {
    static constexpr bool PERM = true, AFTER_DRAIN = false, KHOOK = (mode == EM_MRG), DUP = (PROBE >= 30 && PROBE <= 36 && PROBE != 31 && mode == EM_INPROJ) || (PROBE == 31 && mode == EM_FF1);
    __device__ __forceinline__ static bool dup_tile(int pn) { return PROBE == 32 ? pn >= 23 : ((PROBE == 33 || PROBE == 36) ? (pn >= 5 && pn < 17) : (PROBE == 34 ? (pn < 2 || (pn >= 17 && pn < 23)) : (PROBE == 35 ? (pn >= 2 && pn < 5) : true))); }
    int S, sshift, flag;
    unsigned char* ws;
    const float* xin; float* xout;
    const LASQ float* rs_lds; int rs_base, rs_on;
    __device__ __forceinline__ static u32x4 pack8(const f32x4& a, const f32x4& b) { u32x4 w; w.x = cvtpk(a[0], a[1]); w.y = cvtpk(a[2], a[3]); w.z = cvtpk(b[0], b[1]); w.w = cvtpk(b[2], b[3]); return w; }
    __device__ __forceinline__ void khook(f32x4 (&acc)[2][2][4][2], const Unit& u, int t, int wr, int wc, int fr, int fq) const {
        const int br = t >> 4; const bf16_t* gates = (const bf16_t*)(ws + WS_GATES) + br * 1024;
        const int row0 = u.pm * BM + wr * 64 + fr, cw = wc * 32 + 8 * fq;
#pragma unroll
        for (int ai = 0; ai < 2; ++ai)
#pragma unroll
            for (int m = 0; m < 4; ++m) { const int row = row0 + ai * HALF + m * 16;
#pragma unroll
                for (int bj = 0; bj < 2; ++bj) { const int C0 = u.pn * 256 + bj * HALF + cw;
                    const u32x4 ga = *(const u32x4*)(gates + (size_t)row * 3072 + C0), gb = *(const u32x4*)(gates + (size_t)row * 3072 + 1024 + C0);
                    f32x4& v0 = acc[ai][bj][m][0]; f32x4& v1 = acc[ai][bj][m][1];
                    v0[0] *= bflo(ga.x) * __builtin_amdgcn_rcpf(bflo(gb.x)); v0[1] *= bfhi(ga.x) * __builtin_amdgcn_rcpf(bfhi(gb.x)); v0[2] *= bflo(ga.y) * __builtin_amdgcn_rcpf(bflo(gb.y)); v0[3] *= bfhi(ga.y) * __builtin_amdgcn_rcpf(bfhi(gb.y));
                    v1[0] *= bflo(ga.z) * __builtin_amdgcn_rcpf(bflo(gb.z)); v1[1] *= bfhi(ga.z) * __builtin_amdgcn_rcpf(bfhi(gb.z)); v1[2] *= bflo(ga.w) * __builtin_amdgcn_rcpf(bflo(gb.w)); v1[3] *= bfhi(ga.w) * __builtin_amdgcn_rcpf(bfhi(gb.w)); } }
    }
    __device__ __forceinline__ static float rstd_of(const sq_t* sq, int row, float invn) { return 1.f / sqrtf((float)sq[row] * (invn * (1.f / 16777216.f)) + RMS_EPS); }
    __device__ __forceinline__ float rstd_row(const sq_t* sq, int row, float invn) const { return rs_on ? rs_lds[row - rs_base] : rstd_of(sq, row, invn); }
    __device__ __forceinline__ static float sumsq8(const f32x4& a, const f32x4& b) { return ((a[0] * a[0] + a[1] * a[1]) + (a[2] * a[2] + a[3] * a[3])) + ((b[0] * b[0] + b[1] * b[1]) + (b[2] * b[2] + b[3] * b[3])); }
    __device__ __forceinline__ static void row_atomic(sq_t* sq, int row, float s, int lane, int fq) { s += shx(s, lane, 16); s += shx(s, lane, 32); if (fq == 0) (void)__hip_atomic_fetch_add(sq + row, (sq_t)(s * 16777216.f), __ATOMIC_RELAXED, __HIP_MEMORY_SCOPE_AGENT); }
    __device__ __forceinline__ void operator()(const f32x4 (&acc)[2][2][4][2], const Unit& u, int wr, int wc, int fr, int fq) const {
        const int row0 = u.pm * BM + wr * 64 + fr;
        const int cw = wc * 32 + 8 * fq;
        const int pn = u.pn, lane = fq * 16 + fr;
        sq_t* SQX = (sq_t*)(ws + WS_STAT); sq_t* SQMID = SQX + TCH; sq_t* SQQ = SQX + 2 * TCH; sq_t* SQKV = SQX + 3 * TCH;
        if (mode == EM_INPROJ) {
            float rs[2][4];
#pragma unroll
            for (int ai = 0; ai < 2; ++ai)
#pragma unroll
                for (int m = 0; m < 4; ++m) rs[ai][m] = rstd_row(SQX, row0 + ai * HALF + m * 16, 1.f / 1024.f);
            if (pn < 2) {
                bf16_t* base = (bf16_t*)(ws + WS_UP); const int coff = pn * 256 + cw;
#pragma unroll
                for (int ai = 0; ai < 2; ++ai)
#pragma unroll
                    for (int m = 0; m < 4; ++m) { bf16_t* rowp = base + (size_t)(row0 + ai * HALF + m * 16) * 512 + coff;
#pragma unroll
                        for (int bj = 0; bj < 2; ++bj) *(u32x4*)(rowp + bj * HALF) = pack8(acc[ai][bj][m][0] * rs[ai][m], acc[ai][bj][m][1] * rs[ai][m]); }
            } else if (pn < 5) {
                bf16_t* base = (bf16_t*)(ws + WS_CQ);
#pragma unroll
                for (int bj = 0; bj < 2; ++bj) { const int hidx = (pn - 2) * 2 + bj;
                    if (hidx < 5) { sq_t* sq = hidx < 3 ? SQQ : SQKV;
#pragma unroll
                        for (int ai = 0; ai < 2; ++ai)
#pragma unroll
                            for (int m = 0; m < 4; ++m) { const int row = row0 + ai * HALF + m * 16; const f32x4 v0 = acc[ai][bj][m][0] * rs[ai][m], v1 = acc[ai][bj][m][1] * rs[ai][m];
                                *(u32x4*)(base + (size_t)row * 768 + hidx * 128 + cw) = pack8(v0, v1); row_atomic(sq, row, sumsq8(v0, v1) * ((PROBE == 1 || PROBE == 30 || PROBE == 35) ? 0.5f : 1.f), lane, fq); }
                    } else if (wc == 0) { const float* cs = (const float*)(ws + WS_CS32); const int f0 = 4 * fq; bf16_t* kb = (bf16_t*)(ws + WS_K);
#pragma unroll
                        for (int ai = 0; ai < 2; ++ai)
#pragma unroll
                            for (int m = 0; m < 4; ++m) { const int row = row0 + ai * HALF + m * 16, pos = row & (S - 1);
                                const f32x4* cp = (const f32x4*)(cs + ((size_t)pos * 16 + f0) * 2); const f32x4 c01 = cp[0], c23 = cp[1];
                                const f32x4 v0 = acc[ai][bj][m][0] * rs[ai][m], v1 = acc[ai][bj][m][1] * rs[ai][m];
                                const float a0 = v0[0] * c01[0] - v0[1] * c01[1], b0 = v0[1] * c01[0] + v0[0] * c01[1];
                                const float a1 = v0[2] * c01[2] - v0[3] * c01[3], b1 = v0[3] * c01[2] + v0[2] * c01[3];
                                const float a2 = v1[0] * c23[0] - v1[1] * c23[1], b2 = v1[1] * c23[0] + v1[0] * c23[1];
                                const float a3 = v1[2] * c23[2] - v1[3] * c23[3], b3 = v1[3] * c23[2] + v1[2] * c23[3];
                                u32x2e w1, w2; w1.x = cvtpk(a0, a1); w1.y = cvtpk(a2, a3); w2.x = cvtpk(b0, b1); w2.y = cvtpk(b2, b3);
                                bf16_t* kp = kb + (size_t)row * 768 + 64 + f0;
#pragma unroll
                                for (int hh = 0; hh < 8; ++hh) { *(u32x2e*)(kp + hh * 96) = w1; *(u32x2e*)(kp + hh * 96 + 16) = w2; } }
                    }
                }
            } else if (pn < 17) {
                const bool isq = pn < 11; bf16_t* base = isq ? (bf16_t*)(ws + WS_QD) : (bf16_t*)(ws + WS_KD); const int hh0 = (isq ? pn - 5 : pn - 11) * 2; const float sc0 = isq ? QSC_DIL : 1.f;
                const int f0 = wc * 16 + 4 * fq; const float* cs = (const float*)(ws + WS_CS128);
#pragma unroll
                for (int ai = 0; ai < 2; ++ai)
#pragma unroll
                    for (int m = 0; m < 4; ++m) { const int row = row0 + ai * HALF + m * 16, pos = row & (S - 1); const float sc = sc0 * rs[ai][m];
                        const f32x4* cp = (const f32x4*)(cs + ((size_t)pos * 64 + f0) * 2); const f32x4 c01 = cp[0], c23 = cp[1];
#pragma unroll
                        for (int bj = 0; bj < 2; ++bj) { const f32x4 v0 = acc[ai][bj][m][0], v1 = acc[ai][bj][m][1];
                            const float a0 = (v0[0] * c01[0] - v0[1] * c01[1]) * sc, b0 = (v0[1] * c01[0] + v0[0] * c01[1]) * sc;
                            const float a1 = (v0[2] * c01[2] - v0[3] * c01[3]) * sc, b1 = (v0[3] * c01[2] + v0[2] * c01[3]) * sc;
                            const float a2 = (v1[0] * c23[0] - v1[1] * c23[1]) * sc, b2 = (v1[1] * c23[0] + v1[0] * c23[1]) * sc;
                            const float a3 = (v1[2] * c23[2] - v1[3] * c23[3]) * sc, b3 = (v1[3] * c23[2] + v1[2] * c23[3]) * sc;
                            u32x2e w1, w2; w1.x = cvtpk(a0, a1); w1.y = cvtpk(a2, a3); w2.x = cvtpk(b0, b1); w2.y = cvtpk(b2, b3);
                            const bool odd = (fq & 1) != 0; const u32x2e snd = odd ? w1 : w2; u32x2e rcv;
                            rcv.x = (unsigned)__builtin_amdgcn_ds_bpermute((lane ^ 16) << 2, (int)snd.x); rcv.y = (unsigned)__builtin_amdgcn_ds_bpermute((lane ^ 16) << 2, (int)snd.y);
                            u32x4 o; if (odd) { o.x = rcv.x; o.y = rcv.y; o.z = w2.x; o.w = w2.y; } else { o.x = w1.x; o.y = w1.y; o.z = rcv.x; o.w = rcv.y; }
                            if (!(flag & 4) || o.x == 0x12345678u) *(u32x4*)(base + (size_t)row * 1536 + (hh0 + bj) * 128 + (odd ? 64 + f0 - 4 : f0)) = o; } }
            } else if (pn < 23) {
                bf16_t* base = (bf16_t*)(ws + WS_VDT); const int coff = (pn - 17) * 256 + cw;
#pragma unroll
                for (int ai = 0; ai < 2; ++ai)
#pragma unroll
                    for (int m = 0; m < 4; ++m) { bf16_t* rowp = base + (size_t)(row0 + ai * HALF + m * 16) * 1536 + coff;
#pragma unroll
                        for (int bj = 0; bj < 2; ++bj) *(u32x4*)(rowp + bj * HALF) = pack8(acc[ai][bj][m][0] * rs[ai][m], acc[ai][bj][m][1] * rs[ai][m]); }
            } else {
                bf16_t* base = (bf16_t*)(ws + WS_GATES); const int coff = (pn - 23) * 256 + cw;
#pragma unroll
                for (int ai = 0; ai < 2; ++ai)
#pragma unroll
                    for (int m = 0; m < 4; ++m) { bf16_t* rowp = base + (size_t)(row0 + ai * HALF + m * 16) * 3072 + coff; const float ns = -1.4426950408889634f * rs[ai][m];
#pragma unroll
                        for (int bj = 0; bj < 2; ++bj) { f32x4 v0 = acc[ai][bj][m][0], v1 = acc[ai][bj][m][1];
#pragma unroll
                            for (int e = 0; e < 4; ++e) { v0[e] = __builtin_amdgcn_rcpf(1.f + fexp2(ns * v0[e])); v1[e] = __builtin_amdgcn_rcpf(1.f + fexp2(ns * v1[e])); }
                            __builtin_nontemporal_store(pack8(v0, v1), (u32x4*)(rowp + bj * HALF)); } }
            }
        } else if (mode == EM_Q) {
            bf16_t* base = (bf16_t*)(ws + WS_Q); const float* cs = (const float*)(ws + WS_CS32);
            float rs[2][4];
#pragma unroll
            for (int ai = 0; ai < 2; ++ai)
#pragma unroll
                for (int m = 0; m < 4; ++m) rs[ai][m] = rstd_row(SQQ, row0 + ai * HALF + m * 16, 1.f / 384.f) * QSC_MLA;
#pragma unroll
            for (int bj = 0; bj < 2; ++bj) { const int C0 = pn * 256 + bj * HALF + cw, head = C0 / 96, w = C0 - head * 96;
                if (w < 64) {
#pragma unroll
                    for (int ai = 0; ai < 2; ++ai)
#pragma unroll
                        for (int m = 0; m < 4; ++m) { const int row = row0 + ai * HALF + m * 16; *(u32x4*)(base + (size_t)row * 768 + C0) = pack8(acc[ai][bj][m][0] * rs[ai][m], acc[ai][bj][m][1] * rs[ai][m]); }
                } else { const int f0 = (w - 64) >> 1;
#pragma unroll
                    for (int ai = 0; ai < 2; ++ai)
#pragma unroll
                        for (int m = 0; m < 4; ++m) { const int row = row0 + ai * HALF + m * 16, pos = row & (S - 1);
                            const f32x4* cp = (const f32x4*)(cs + ((size_t)pos * 16 + f0) * 2); const f32x4 c01 = cp[0], c23 = cp[1];
                            const f32x4 v0 = acc[ai][bj][m][0], v1 = acc[ai][bj][m][1]; const float sc = rs[ai][m];
                            const float a0 = (v0[0] * c01[0] - v0[1] * c01[1]) * sc, b0 = (v0[1] * c01[0] + v0[0] * c01[1]) * sc;
                            const float a1 = (v0[2] * c01[2] - v0[3] * c01[3]) * sc, b1 = (v0[3] * c01[2] + v0[2] * c01[3]) * sc;
                            const float a2 = (v1[0] * c23[0] - v1[1] * c23[1]) * sc, b2 = (v1[1] * c23[0] + v1[0] * c23[1]) * sc;
                            const float a3 = (v1[2] * c23[2] - v1[3] * c23[3]) * sc, b3 = (v1[3] * c23[2] + v1[2] * c23[3]) * sc;
                            bf16_t* hp = base + (size_t)row * 768 + head * 96 + 64 + f0;
                            u32x2e w1, w2; w1.x = cvtpk(a0, a1); w1.y = cvtpk(a2, a3); w2.x = cvtpk(b0, b1); w2.y = cvtpk(b2, b3);
                            *(u32x2e*)hp = w1; *(u32x2e*)(hp + 16) = w2; } }
            }
        } else if (mode == EM_K || mode == EM_V) {
            bf16_t* kbase = (bf16_t*)(ws + WS_K); bf16_t* vbase = (bf16_t*)(ws + WS_VT);
#pragma unroll
            for (int ai = 0; ai < 2; ++ai)
#pragma unroll
                for (int m = 0; m < 4; ++m) { const int row = row0 + ai * HALF + m * 16, pos = row & (S - 1), seq = row >> sshift; const float r = rstd_row(SQKV, row, 1.f / 256.f);
#pragma unroll
                    for (int bj = 0; bj < 2; ++bj) { const int C0 = (pn & 1) * 256 + bj * HALF + cw, head = C0 >> 6, w = C0 & 63;
                        const f32x4 v0 = acc[ai][bj][m][0] * r, v1 = acc[ai][bj][m][1] * r;
                        if (pn < 2) *(u32x4*)(kbase + (size_t)row * 768 + head * 96 + w) = pack8(v0, v1);
                        else { bf16_t* vp = vbase + ((size_t)((seq * 8 + head) * 64 + w)) * S + pos;
                            vp[0] = f2bf(v0[0]); vp[(size_t)S] = f2bf(v0[1]); vp[(size_t)2 * S] = f2bf(v0[2]); vp[(size_t)3 * S] = f2bf(v0[3]);
                            vp[(size_t)4 * S] = f2bf(v1[0]); vp[(size_t)5 * S] = f2bf(v1[1]); vp[(size_t)6 * S] = f2bf(v1[2]); vp[(size_t)7 * S] = f2bf(v1[3]); } } }
        } else if (mode == EM_MRG) {
            const bf16_t* gates = (const bf16_t*)(ws + WS_GATES); bf16_t* mrg = (bf16_t*)(ws + WS_MRG);
#pragma unroll
            for (int ai = 0; ai < 2; ++ai)
#pragma unroll
                for (int m = 0; m < 4; ++m) { const int row = row0 + ai * HALF + m * 16;
#pragma unroll
                    for (int bj = 0; bj < 2; ++bj) { const int C0 = pn * 256 + bj * HALF + cw;
                        const u32x4 g = *(const u32x4*)(gates + (size_t)row * 3072 + 2048 + C0);
                        f32x4 v0 = acc[ai][bj][m][0], v1 = acc[ai][bj][m][1];
                        v0[0] *= bflo(g.x); v0[1] *= bfhi(g.x); v0[2] *= bflo(g.y); v0[3] *= bfhi(g.y); v1[0] *= bflo(g.z); v1[1] *= bfhi(g.z); v1[2] *= bflo(g.w); v1[3] *= bfhi(g.w);
                        *(u32x4*)(mrg + (size_t)row * 1024 + C0) = pack8(v0, v1); } }
        } else if (mode == EM_WO || mode == EM_FF2) {
            const bf16_t* hb = (const bf16_t*)(ws + WS_H); bf16_t* dst = (mode == EM_FF2 && flag) ? (bf16_t*)(ws + WS_MRG) : (bf16_t*)(ws + WS_H);
            sq_t* sq = mode == EM_WO ? SQMID : (flag ? SQX + 4 * TCH : SQX);
#pragma unroll
            for (int ai = 0; ai < 2; ++ai)
#pragma unroll
                for (int m = 0; m < 4; ++m) { const int row = row0 + ai * HALF + m * 16; float ss = 0.f;
#pragma unroll
                    for (int bj = 0; bj < 2; ++bj) { const size_t o = (size_t)row * 1024 + pn * 256 + bj * HALF + cw;
                        const u32x4 xi = *(const u32x4*)(hb + o); f32x4 r0 = acc[ai][bj][m][0], r1 = acc[ai][bj][m][1];
                        r0[0] += bflo(xi.x); r0[1] += bfhi(xi.x); r0[2] += bflo(xi.y); r0[3] += bfhi(xi.y); r1[0] += bflo(xi.z); r1[1] += bfhi(xi.z); r1[2] += bflo(xi.w); r1[3] += bfhi(xi.w);
                        *(u32x4*)(dst + o) = pack8(r0, r1); ss += sumsq8(r0, r1); }
                    row_atomic(sq, row, ss, lane, fq); }
        } else {
            bf16_t* base = (bf16_t*)(ws + WS_FF);
#pragma unroll
            for (int ai = 0; ai < 2; ++ai)
#pragma unroll
                for (int m = 0; m < 4; ++m) { const int row = row0 + ai * HALF + m * 16; bf16_t* rowp = base + (size_t)row * 4096 + pn * 256 + cw; const float r = rstd_row(SQMID, row, 1.f / 1024.f);
#pragma unroll
                    for (int bj = 0; bj < 2; ++bj) { f32x4 v0 = acc[ai][bj][m][0], v1 = acc[ai][bj][m][1];
#pragma unroll
                        for (int e = 0; e < 4; ++e) { const float x0 = fmaxf(v0[e], 0.f) * r, x1 = fmaxf(v1[e], 0.f) * r; v0[e] = x0 * x0; v1[e] = x1 * x1; }
                        *(u32x4*)(rowp + bj * HALF) = pack8(v0, v1); } }
        }
    }
};

template <class Epi, class Sched, bool ALIGN_EPI = false, bool SP2 = false>
__device__ __forceinline__ void gemm_phase(PG8_LAS unsigned char* lds, const Gemm g, const Sched& S, const Epi& E, const int tid) {
    const int wid = __builtin_amdgcn_readfirstlane(tid >> 6), lane = tid & 63, wr = wid >> 2, wc = wid & 3, fr = lane & 15, fq = lane >> 4;
    const int K = g.K, nt = K / BK;
    unsigned voffA[2], voffB[2];
#pragma unroll
    for (int i = 0; i < 2; ++i) { int R, C; stage_rc(tid * 16 + i * 8192, R, C); const int Rb = Epi::PERM ? ((R & ~31) + perm32(R & 31)) : R;
        voffA[i] = (unsigned)(R * g.lda + C) * 2u; voffB[i] = (unsigned)(Rb * K + C) * 2u; }
    const size_t kstep = (size_t)(BK * 2);
    const size_t hstepA = (size_t)HALF * g.lda * 2, hstepB = (size_t)HALF * K * 2;
    const size_t tstepA = 2 * hstepA, tstepB = 2 * hstepB;
    const unsigned ldsw = (unsigned)wid * 1024u;
    const int aoff = lds_byte(wr * 64 + fr, fq * 8), boff = lds_byte(wc * 32 + fr, fq * 8);
#define PG8_SA(b, h) (((b) * 2 + (h)) * HTB)
#define PG8_SB(b, h) ((4 + (b) * 2 + (h)) * HTB)
#define PG8_STAGE(bufoff, gbase, voff) do { _Pragma("unroll") for (int _i = 0; _i < 2; ++_i) \
        __builtin_amdgcn_global_load_lds((const unsigned*)((const char*)(gbase) + (voff)[_i]), (PG8_LAS unsigned*)(lds + (bufoff) + ldsw + _i * 8192), 16, 0, 0); } while (0)
#define PG8_LDA(dst, b, h) do { _Pragma("unroll") for (int m = 0; m < 4; ++m) _Pragma("unroll") for (int k = 0; k < 2; ++k) dst[m][k] = *(const PG8_LAS bf16x8*)(lds + PG8_SA(b, h) + aoff + m * 2048 + k * 1024); } while (0)
#define PG8_LDB(dst, b, h) do { _Pragma("unroll") for (int n = 0; n < 2; ++n) _Pragma("unroll") for (int k = 0; k < 2; ++k) dst[n][k] = *(const PG8_LAS bf16x8*)(lds + PG8_SB(b, h) + boff + n * 2048 + k * 1024); } while (0)
#define PG8_MMA(ai, bj, At, Bt) do { __builtin_amdgcn_s_setprio(1); _Pragma("unroll") for (int m = 0; m < 4; ++m) _Pragma("unroll") for (int n = 0; n < 2; ++n) _Pragma("unroll") for (int k = 0; k < 2; ++k) \
        acc[ai][bj][m][n] = __builtin_amdgcn_mfma_f32_16x16x32_bf16(Bt[n][k], At[m][k], acc[ai][bj][m][n], 0, 0, 0); __builtin_amdgcn_s_setprio(0); } while (0)
#define PG8_WAIT_V(n) asm volatile("s_waitcnt vmcnt(" #n ")" ::: "memory")
#define PG8_WAIT_L(n) asm volatile("s_waitcnt lgkmcnt(" #n ")" ::: "memory")
#define PG8_BAR __builtin_amdgcn_s_barrier()
#define PG8_SCHED __builtin_amdgcn_sched_barrier(0)
    Unit cur, nxt; int ui = 0;
    if (!S.next(0, cur)) return;
    f32x4 acc[2][2][4][2];
#pragma unroll
    for (int a = 0; a < 2; ++a)
#pragma unroll
        for (int b = 0; b < 2; ++b)
#pragma unroll
            for (int m = 0; m < 4; ++m)
#pragma unroll
                for (int n = 0; n < 2; ++n) acc[a][b][m][n] = (f32x4){0.f, 0.f, 0.f, 0.f};
    bf16x8 At[4][2], B0[2][2], B1[2][2];
    const char* cA = (const char*)g.A + (size_t)cur.pm * tstepA; const char* cB = (const char*)g.Bt + (size_t)cur.pn * tstepB;
    S.a_ready(cur);
    if constexpr (SP2) {
        PG8_STAGE(PG8_SB(0, 0), cB, voffB); PG8_STAGE(PG8_SB(0, 1), cB + hstepB, voffB); PG8_STAGE(PG8_SA(0, 0), cA, voffA); PG8_STAGE(PG8_SA(0, 1), cA + hstepA, voffA);
        if (wr == 1) PG8_BAR;
        PG8_WAIT_V(2); PG8_BAR;
        PG8_STAGE(PG8_SB(1, 0), cB + kstep, voffB); PG8_STAGE(PG8_SA(1, 0), cA + kstep, voffA); PG8_STAGE(PG8_SB(1, 1), cB + hstepB + kstep, voffB);
        PG8_WAIT_V(6); PG8_BAR;
    } else {
        PG8_STAGE(PG8_SB(0, 0), cB, voffB); PG8_STAGE(PG8_SA(0, 0), cA, voffA); PG8_STAGE(PG8_SB(0, 1), cB + hstepB, voffB); PG8_STAGE(PG8_SA(0, 1), cA + hstepA, voffA);
        if (wr == 1) PG8_BAR;
        PG8_WAIT_V(4); PG8_BAR;
        PG8_STAGE(PG8_SB(1, 0), cB + kstep, voffB); PG8_STAGE(PG8_SA(1, 0), cA + kstep, voffA); PG8_STAGE(PG8_SB(1, 1), cB + hstepB + kstep, voffB);
        PG8_WAIT_V(6); PG8_BAR;
    }
    for (;;) {
        const bool has_next = S.next(ui + 1, nxt);
        const char* nA = has_next ? (const char*)g.A + (size_t)nxt.pm * tstepA : cA; const char* nB = has_next ? (const char*)g.Bt + (size_t)nxt.pn * tstepB : cB;
        for (int t = 0; t < nt; t += 2) {
            if constexpr (Epi::KHOOK) { if (t == 8 || t == 16) E.khook(acc, cur, t, wr, wc, fr, fq); }
            const bool last = (t == nt - 2);
            const char* a1 = cA + (size_t)(t + 1) * kstep;
            const char* a2 = last ? nA : cA + (size_t)(t + 2) * kstep; const char* b2 = last ? nB : cB + (size_t)(t + 2) * kstep;
            const char* a3 = a2 + kstep; const char* b3 = b2 + kstep;
            if (last && has_next) S.a_ready(nxt);
            if constexpr (SP2) {
            PG8_LDB(B0, 0, 0); PG8_LDB(B1, 0, 1); PG8_SCHED; PG8_LDA(At, 0, 0); PG8_STAGE(PG8_SA(1, 1), a1 + hstepA, voffA);
            PG8_WAIT_V(8); PG8_WAIT_L(0); PG8_BAR; PG8_MMA(0, 0, At, B0); PG8_MMA(0, 1, At, B1); PG8_BAR; PG8_SCHED;
            PG8_LDA(At, 0, 1); PG8_STAGE(PG8_SB(0, 0), b2, voffB); PG8_STAGE(PG8_SB(0, 1), b2 + hstepB, voffB); PG8_STAGE(PG8_SA(0, 0), a2, voffA);
            PG8_WAIT_V(8); PG8_WAIT_L(0); PG8_BAR; PG8_MMA(1, 0, At, B0); PG8_MMA(1, 1, At, B1); PG8_BAR; PG8_SCHED;
            PG8_LDB(B0, 1, 0); PG8_LDB(B1, 1, 1); PG8_SCHED; PG8_LDA(At, 1, 0); PG8_STAGE(PG8_SA(0, 1), a2 + hstepA, voffA);
            PG8_WAIT_V(8); PG8_WAIT_L(0); PG8_BAR; PG8_MMA(0, 0, At, B0); PG8_MMA(0, 1, At, B1); PG8_BAR; PG8_SCHED;
            PG8_LDA(At, 1, 1); PG8_STAGE(PG8_SB(1, 0), b3, voffB); PG8_STAGE(PG8_SB(1, 1), b3 + hstepB, voffB); PG8_STAGE(PG8_SA(1, 0), a3, voffA);
            PG8_WAIT_V(8); PG8_WAIT_L(0); PG8_BAR; PG8_MMA(1, 0, At, B0); PG8_MMA(1, 1, At, B1); PG8_BAR; PG8_SCHED;
            } else {
            PG8_LDB(B0, 0, 0); PG8_SCHED; PG8_LDA(At, 0, 0); PG8_STAGE(PG8_SA(1, 1), a1 + hstepA, voffA);
            PG8_WAIT_L(8); PG8_BAR; PG8_WAIT_L(0); PG8_MMA(0, 0, At, B0); PG8_BAR; PG8_SCHED;
            PG8_LDB(B1, 0, 1); PG8_STAGE(PG8_SB(0, 0), b2, voffB);
            PG8_BAR; PG8_WAIT_L(0); PG8_MMA(0, 1, At, B1); PG8_BAR;
            PG8_LDA(At, 0, 1); PG8_STAGE(PG8_SA(0, 0), a2, voffA);
            PG8_BAR; PG8_WAIT_L(0); PG8_MMA(1, 0, At, B0); PG8_BAR; PG8_SCHED;
            PG8_STAGE(PG8_SB(0, 1), b2 + hstepB, voffB);
            PG8_WAIT_V(6); PG8_BAR; PG8_MMA(1, 1, At, B1); PG8_BAR;
            PG8_LDB(B0, 1, 0); PG8_SCHED; PG8_LDA(At, 1, 0); PG8_STAGE(PG8_SA(0, 1), a2 + hstepA, voffA);
            PG8_WAIT_L(8); PG8_BAR; PG8_WAIT_L(0); PG8_MMA(0, 0, At, B0); PG8_BAR; PG8_SCHED;
            PG8_LDB(B1, 1, 1); PG8_STAGE(PG8_SB(1, 0), b3, voffB);
            PG8_BAR; PG8_WAIT_L(0); PG8_MMA(0, 1, At, B1); PG8_BAR;
            PG8_LDA(At, 1, 1); PG8_STAGE(PG8_SA(1, 0), a3, voffA);
            PG8_BAR; PG8_WAIT_L(0); PG8_MMA(1, 0, At, B0); PG8_BAR; PG8_SCHED;
            PG8_STAGE(PG8_SB(1, 1), b3 + hstepB, voffB);
            PG8_WAIT_V(6); PG8_BAR; PG8_MMA(1, 1, At, B1); PG8_BAR;
            }
        }
        if constexpr (ALIGN_EPI) { if (wr == 0) PG8_BAR; }
        if constexpr (!Epi::AFTER_DRAIN) { E(acc, cur, wr, wc, fr, fq); if constexpr (Epi::DUP) { if (Epi::dup_tile(cur.pn)) { Epi E2 = E; if (PROBE == 36) E2.flag |= 4; E2(acc, cur, wr, wc, fr, fq); } } S.done(cur); }
        if (!has_next) break;
#pragma unroll
        for (int a = 0; a < 2; ++a)
#pragma unroll
            for (int b = 0; b < 2; ++b)
#pragma unroll
                for (int m = 0; m < 4; ++m)
#pragma unroll
                    for (int n = 0; n < 2; ++n) acc[a][b][m][n] = (f32x4){0.f, 0.f, 0.f, 0.f};
        cur = nxt; cA = nA; cB = nB; ++ui;
        if constexpr (ALIGN_EPI) { if (wr == 1) PG8_BAR; }
    }
    PG8_WAIT_V(0);
    if constexpr (!ALIGN_EPI) { if (wr == 0) PG8_BAR; }
    PG8_BAR;
    if constexpr (Epi::AFTER_DRAIN) { E.fused(acc, cur, wr, wc, fr, fq, lds, wid, lane); S.done(cur); }
#undef PG8_SA
#undef PG8_SB
#undef PG8_STAGE
#undef PG8_LDA
#undef PG8_LDB
#undef PG8_MMA
#undef PG8_WAIT_V
#undef PG8_WAIT_L
#undef PG8_BAR
#undef PG8_SCHED
}
}

using pg8::bf16_t; using pg8::bf16x8; using pg8::f32x4; using pg8::u32x4;
#define MFMA32(a, b, c) __builtin_amdgcn_mfma_f32_32x32x16_bf16((a), (b), (c), 0, 0, 0)

DI int win_src(int n) {
    if (n < 512) return n;
    if (n < 1280) { const int j = n - 512; if (j < 640) return 512 + j; if (j >= 672) return -1; const int p = j - 640; return 1152 + (p >> 1) + 16 * (p & 1); }
    if (n < 4352) { int q = n - 1280, base = 1184; if (q >= 1536) { q -= 1536; base = 2720; } const int hh = q >> 7, p = q & 127; return base + hh * 128 + (p >> 1) + 64 * (p & 1); }
    if (n < 5888) return 4256 + (n - 4352);
    return 5792 + (n - 5888);
}
DI int wuq_src(int n) { const int head = n / 96, w = n - head * 96; if (w < 64) return n; const int p = w - 64; return head * 96 + 64 + (p >> 1) + 16 * (p & 1); }

template <int MAP> DI void conv_items(const float* __restrict__ W, int K, int Nsrc, bf16_t* __restrict__ dst, int Nphys, int gtid, int NGT, int ldd = 0, int coff = 0, const float* __restrict__ gain = nullptr) {
    if (ldd == 0) ldd = K;
    const int nitems = Nphys * (K >> 3);
#pragma unroll 4
    for (int it = gtid; it < nitems; it += NGT) {
        const int n = it % Nphys, kg = it / Nphys; const int src = MAP == 1 ? win_src(n) : (MAP == 2 ? wuq_src(n) : n);
        u32x4 o = {0u, 0u, 0u, 0u};
        if (src >= 0) { const float* p = W + (size_t)(kg * 8) * Nsrc + src;
            float v0 = p[0], v1 = p[(size_t)Nsrc], v2 = p[(size_t)2 * Nsrc], v3 = p[(size_t)3 * Nsrc], v4 = p[(size_t)4 * Nsrc], v5 = p[(size_t)5 * Nsrc], v6 = p[(size_t)6 * Nsrc], v7 = p[(size_t)7 * Nsrc];
            if (gain) { const f32x4 g0 = *(const f32x4*)(gain + kg * 8), g1 = *(const f32x4*)(gain + kg * 8 + 4); v0 *= g0[0]; v1 *= g0[1]; v2 *= g0[2]; v3 *= g0[3]; v4 *= g1[0]; v5 *= g1[1]; v6 *= g1[2]; v7 *= g1[3]; }
            o.x = cvtpk(v0, v1); o.y = cvtpk(v2, v3); o.z = cvtpk(v4, v5); o.w = cvtpk(v6, v7); }
        *(u32x4*)(dst + (size_t)n * ldd + coff + kg * 8) = o;
    }
}
DI void conv_weff(const float* poolw, const float* scale, const float* wa, bf16_t* dst, int gtid, int NGT) {
    for (int it = gtid; it < 1024 * 64; it += NGT) {
        const int n = it & 1023, kg = it >> 10, k0 = kg * 8, g = k0 >> 7, c0 = k0 & 127;
        float a0 = 0.f, a1 = 0.f, a2 = 0.f, a3 = 0.f, a4 = 0.f, a5 = 0.f, a6 = 0.f, a7 = 0.f;
        const float* pw = poolw + ((size_t)g * 128 + c0) * 128;
        for (int d = 0; d < 128; ++d) { const float wv = scale[g * 128 + d] * wa[(size_t)(g * 128 + d) * 1024 + n];
            a0 += pw[d] * wv; a1 += pw[128 + d] * wv; a2 += pw[256 + d] * wv; a3 += pw[384 + d] * wv; a4 += pw[512 + d] * wv; a5 += pw[640 + d] * wv; a6 += pw[768 + d] * wv; a7 += pw[896 + d] * wv; }
        u32x4 o; o.x = cvtpk(a0, a1); o.y = cvtpk(a2, a3); o.z = cvtpk(a4, a5); o.w = cvtpk(a6, a7);
        *(u32x4*)(dst + (size_t)n * 1536 + k0) = o;
    }
}
DI void rope_table(float* cs, int half, double cbase, int gtid, int NGT) {
    const int n = 8192 * half;
    for (int it = gtid; it < n; it += NGT) {
        const int pos = it / half, f = it - pos * half;
        double inv = 1.0; for (int i = 0; i < f; ++i) inv *= cbase;
        const double rev = (double)pos * inv * 0.15915494309189535;
        const float fr = (float)(rev - __builtin_rint(rev));
        cs[2 * (size_t)it] = __builtin_amdgcn_cosf(fr); cs[2 * (size_t)it + 1] = __builtin_amdgcn_sinf(fr);
    }
}

DI void rms_rows_bf16(const float* x, const float* g, bf16_t* out, int nrows, int gw, int NGW, int lane) {
    for (int row = gw; row < nrows; row += NGW) {
        const f32x4* xr = (const f32x4*)(x + (size_t)row * 1024) + lane; f32x4 v[4]; float s = 0.f;
#pragma unroll
        for (int j = 0; j < 4; ++j) { v[j] = xr[64 * j]; s += (v[j][0] * v[j][0] + v[j][1] * v[j][1]) + (v[j][2] * v[j][2] + v[j][3] * v[j][3]); }
        const float rstd = 1.f / sqrtf(wave_sum(s, lane) * (1.f / 1024.f) + RMS_EPS);
        u32x2* o8 = (u32x2*)(out + (size_t)row * 1024) + lane;
#pragma unroll
        for (int j = 0; j < 4; ++j) { const f32x4 gg = ((const f32x4*)g)[lane + 64 * j]; u32x2 w; w.x = cvtpk(v[j][0] * rstd * gg[0], v[j][1] * rstd * gg[1]); w.y = cvtpk(v[j][2] * rstd * gg[2], v[j][3] * rstd * gg[3]); o8[64 * j] = w; }
    }
}
DI void final_rows(const bf16_t* x, const sq_t* sq, const float* g, float* out, int nrows, int gw, int NGW, int lane) {
    for (int row0 = gw; row0 < nrows; row0 += 4 * NGW) {
        u32x2 v[4][4]; float rstd[4];
#pragma unroll
        for (int u = 0; u < 4; ++u) { const int row = row0 + u * NGW; if (row < nrows) { const u32x2* xr = (const u32x2*)(x + (size_t)row * 1024) + lane;
#pragma unroll
                for (int j = 0; j < 4; ++j) v[u][j] = xr[64 * j];
                rstd[u] = 1.f / sqrtf((float)sq[row] * (1.f / 1024.f / 16777216.f) + RMS_EPS); } }
#pragma unroll
        for (int u = 0; u < 4; ++u) { const int row = row0 + u * NGW; if (row < nrows) { f32x4* o = (f32x4*)(out + (size_t)row * 1024) + lane;
#pragma unroll
                for (int j = 0; j < 4; ++j) { const f32x4 gg = ((const f32x4*)g)[lane + 64 * j]; const float r = rstd[u];
                    f32x4 y; y[0] = bflo(v[u][j].x) * r * gg[0]; y[1] = bfhi(v[u][j].x) * r * gg[1]; y[2] = bflo(v[u][j].y) * r * gg[2]; y[3] = bfhi(v[u][j].y) * r * gg[3]; __builtin_nontemporal_store(y, &o[64 * j]); } } }
    }
}
DI void unpack8(const u32x4& r, float (&v)[8]) { v[0] = bflo(r.x); v[1] = bfhi(r.x); v[2] = bflo(r.y); v[3] = bfhi(r.y); v[4] = bflo(r.z); v[5] = bfhi(r.z); v[6] = bflo(r.w); v[7] = bfhi(r.w); }
DI void p0_rows(const float* x, bf16_t* out, sq_t* sq, int nrows, int gw, int NGW, int lane) {
    for (int row0 = gw; row0 < nrows; row0 += 4 * NGW) {
        f32x4 v[4][4];
#pragma unroll
        for (int u = 0; u < 4; ++u) { const int row = row0 + u * NGW; if (row < nrows) { const f32x4* xr = (const f32x4*)(x + (size_t)row * 1024) + lane;
#pragma unroll
                for (int j = 0; j < 4; ++j) v[u][j] = __builtin_nontemporal_load(&xr[64 * j]); } }
#pragma unroll
        for (int u = 0; u < 4; ++u) { const int row = row0 + u * NGW; if (row < nrows) { float s = 0.f;
#pragma unroll
                for (int j = 0; j < 4; ++j) s += (v[u][j][0] * v[u][j][0] + v[u][j][1] * v[u][j][1]) + (v[u][j][2] * v[u][j][2] + v[u][j][3] * v[u][j][3]);
                s = wave_sum(s, lane);
                u32x2* o8 = (u32x2*)(out + (size_t)row * 1024) + lane;
#pragma unroll
                for (int j = 0; j < 4; ++j) { u32x2 w; w.x = cvtpk(v[u][j][0], v[u][j][1]); w.y = cvtpk(v[u][j][2], v[u][j][3]); o8[64 * j] = w; }
                if (lane == 0) sq[row] = (sq_t)(s * 16777216.f); } }
    }
}
DI void pool_rows(unsigned char* ws, int S, int gw, int NGW, int lane) {
    const bf16_t* UP = (const bf16_t*)(ws + WS_UP); bf16_t* MIX = (bf16_t*)(ws + WS_BR);
    for (int t = gw; t < TCH; t += NGW) {
        const int pos = t & (S - 1);
        const int g = lane >> 4, hw = 1 << g; const int lo = max(pos - hw, 0), hi = min(pos + hw, S); const size_t tb = (size_t)(t - pos);
        float a[8] = {0.f, 0.f, 0.f, 0.f, 0.f, 0.f, 0.f, 0.f};
        for (int j = lo; j < hi; ++j) { float v[8]; const u32x4 raw = *(const u32x4*)(UP + (tb + j) * 512 + lane * 8); unpack8(raw, v);
#pragma unroll
            for (int i = 0; i < 8; ++i) a[i] += v[i]; }
        const float rc = 1.f / (float)(hi - lo); float sv[8]; const u32x4 raw = *(const u32x4*)(UP + (size_t)t * 512 + lane * 8); unpack8(raw, sv);
        u32x4 o; o.x = cvtpk(a[0] * rc - sv[0], a[1] * rc - sv[1]); o.y = cvtpk(a[2] * rc - sv[2], a[3] * rc - sv[3]); o.z = cvtpk(a[4] * rc - sv[4], a[5] * rc - sv[5]); o.w = cvtpk(a[6] * rc - sv[6], a[7] * rc - sv[7]);
        *(u32x4*)(MIX + (size_t)t * 1536 + lane * 8) = o;
    }
}
DI void zero_sq(sq_t* p, int n, int gtid, int NGT) {
#pragma clang loop unroll(disable) vectorize(disable)
    for (int i = gtid; i < n; i += NGT) p[i] = 0ull;
}
DI void t2_rows(unsigned char* ws, int gw, int NGW, int lane) {
    const bf16_t* OG = (const bf16_t*)(ws + WS_OG); const float* LSE = (const float*)(ws + WS_LSE); bf16_t* CB = (bf16_t*)(ws + WS_BR) + 1024;
    const int head = lane >> 4;
    for (int t0 = gw; t0 < TCH; t0 += 2 * NGW) {
        u32x4 raw[2][3]; float ls[2][3];
#pragma unroll
        for (int u = 0; u < 2; ++u) { const int t = t0 + u * NGW; if (t < TCH) {
#pragma unroll
                for (int gq = 0; gq < 3; ++gq) { ls[u][gq] = LSE[((size_t)gq * TCH + t) * 4 + head]; raw[u][gq] = *(const u32x4*)(OG + ((size_t)gq * TCH + t) * 512 + lane * 8); } } }
#pragma unroll
        for (int u = 0; u < 2; ++u) { const int t = t0 + u * NGW; if (t < TCH) {
                const float M = fmaxf(ls[u][0], fmaxf(ls[u][1], ls[u][2])); float w0 = fexp2(ls[u][0] - M), w1 = fexp2(ls[u][1] - M), w2 = fexp2(ls[u][2] - M); const float rs = 1.f / (w0 + w1 + w2); w0 *= rs; w1 *= rs; w2 *= rs;
                float v0[8], v1[8], v2[8]; unpack8(raw[u][0], v0); unpack8(raw[u][1], v1); unpack8(raw[u][2], v2);
                float r[8];
#pragma unroll
                for (int i = 0; i < 8; ++i) r[i] = w0 * v0[i] + w1 * v1[i] + w2 * v2[i];
                u32x4 o; o.x = cvtpk(r[0], r[1]); o.y = cvtpk(r[2], r[3]); o.z = cvtpk(r[4], r[5]); o.w = cvtpk(r[6], r[7]);
                *(u32x4*)(CB + (size_t)t * 1536 + lane * 8) = o; } }
    }
}

DI float vmax16(const f32x16& s) { return fmaxf(fmaxf(fmaxf(fmaxf(s[0], s[1]), fmaxf(s[2], s[3])), fmaxf(fmaxf(s[4], s[5]), fmaxf(s[6], s[7]))), fmaxf(fmaxf(fmaxf(s[8], s[9]), fmaxf(s[10], s[11])), fmaxf(fmaxf(s[12], s[13]), fmaxf(s[14], s[15])))); }
DI float exp_sum16(f32x16& s, float m) { float t = 0.f;
#pragma unroll
    for (int i = 0; i < 16; ++i) { s[i] = fexp2(s[i] - m); t += s[i]; }
    return t; }
DI bf16x8 packp(const f32x16& p, const int s2) { u32x4 w; w.x = cvtpk(p[8 * s2], p[8 * s2 + 1]); w.y = cvtpk(p[8 * s2 + 2], p[8 * s2 + 3]); w.z = cvtpk(p[8 * s2 + 4], p[8 * s2 + 5]); w.w = cvtpk(p[8 * s2 + 6], p[8 * s2 + 7]); return __builtin_bit_cast(bf16x8, w); }
DI bf16x8 cat44(const s16x4& lo, const s16x4& hi) { return __builtin_shufflevector(lo, hi, 0, 1, 2, 3, 4, 5, 6, 7); }
DI f32x16 zero16() { f32x16 z;
#pragma unroll
    for (int i = 0; i < 16; ++i) z[i] = 0.f;
    return z; }

constexpr int MLA_KP = 208, MLA_VP = 136, MLA_KBYTES = 64 * MLA_KP, MLA_VBYTES = 64 * MLA_VP, MLA_BUF = MLA_KBYTES + MLA_VBYTES, MLA_SLOT = 2 * MLA_BUF;
template <bool FAST> DI bool mla_unit(unsigned char* lds, unsigned char* ws, int seq, int head, int qb, int S, int tid, int wave, int lane) {
    const bf16_t* Q = (const bf16_t*)(ws + WS_Q); const bf16_t* K = (const bf16_t*)(ws + WS_K); const bf16_t* VT = (const bf16_t*)(ws + WS_VT); bf16_t* BB = (bf16_t*)(ws + WS_BR) + 512;
    const int r = lane & 31, h = lane >> 5;
    const size_t tokq = (size_t)seq * S + qb * 256 + wave * 32 + r;
    const bf16_t* qp = Q + tokq * 768 + head * 96 + 8 * h;
    bf16x8 qf[6];
#pragma unroll
    for (int s = 0; s < 6; ++s) qf[s] = *(const bf16x8*)(qp + 16 * s);
    f32x16 o0 = zero16(), o1 = zero16(); float mrun = -1e30f, lrun = 0.f;
    const int kr0 = tid / 12, kc0 = tid - kr0 * 12; const int t2_ = tid < 256 ? tid + 512 : tid; const int kr1 = t2_ / 12, kc1 = t2_ - kr1 * 12;
    const int vr = tid >> 3, vc = tid & 7;
    const bf16_t* kbase = K + ((size_t)seq * S) * 768 + head * 96;
    const bf16_t* vbase = VT + ((size_t)(seq * 8 + head) * 64) * S;
    u32x4 kA0, kB0, vv0, kA1, kB1, vv1;
#define MLA_LOAD(it) do { const int key0_ = (it) * 128; const bf16_t* k0_ = kbase + (size_t)(key0_ + kr0) * 768 + kc0 * 8; const bf16_t* k1_ = kbase + (size_t)(key0_ + kr1) * 768 + kc1 * 8; const bf16_t* v_ = vbase + (size_t)vr * S + key0_ + vc * 8; \
        kA0 = *(const u32x4*)k0_; kB0 = *(const u32x4*)k1_; vv0 = *(const u32x4*)v_; kA1 = *(const u32x4*)(k0_ + 64 * 768); kB1 = *(const u32x4*)(k1_ + 64 * 768); vv1 = *(const u32x4*)(v_ + 64); } while (0)
#define MLA_ST1(b_, kA, kB, vv) do { *(u32x4*)((b_) + kr0 * MLA_KP + kc0 * 16) = kA; *(u32x4*)((b_) + kr1 * MLA_KP + kc1 * 16) = kB; \
        unsigned char* v_ = (b_) + MLA_KBYTES + vr * MLA_VP + vc * 16; u32x2 lo_, hi_; lo_.x = vv.x; lo_.y = vv.y; hi_.x = vv.z; hi_.y = vv.w; *(u32x2*)v_ = lo_; *(u32x2*)(v_ + 8) = hi_; } while (0)
#define MLA_STORE(slot) do { unsigned char* sb_ = lds + (slot) * MLA_SLOT; MLA_ST1(sb_, kA0, kB0, vv0); MLA_ST1(sb_ + MLA_BUF, kA1, kB1, vv1); } while (0)
#define MLA_KL(ka, u) do { const unsigned char* kb_ = sl + ((u) >> 1) * MLA_BUF + (32 * ((u) & 1) + r) * MLA_KP + 16 * h; _Pragma("unroll") for (int s = 0; s < 6; ++s) ka[s] = *(const bf16x8*)(kb_ + 32 * s); } while (0)
#define MLA_QK(sx, ka) do { sx = zero16(); _Pragma("unroll") for (int s = 0; s < 6; ++s) sx = MFMA32(ka[s], qf[s], sx); } while (0)
#define MLA_VL(va, vc2, u) do { const unsigned char* vb_ = sl + ((u) >> 1) * MLA_BUF + MLA_KBYTES + r * MLA_VP + 8 * h + 64 * ((u) & 1); \
        _Pragma("unroll") for (int j = 0; j < 2; ++j) { va[j] = cat44(*(const s16x4*)(vb_ + 32 * j), *(const s16x4*)(vb_ + 32 * j + 16)); vc2[j] = cat44(*(const s16x4*)(vb_ + 32 * MLA_VP + 32 * j), *(const s16x4*)(vb_ + 32 * MLA_VP + 32 * j + 16)); } } while (0)
#define MLA_SMF(sx, pa, pb) do { float ps_ = 0.f; _Pragma("unroll") for (int i = 0; i < 16; ++i) { sx[i] = fexp2(sx[i]); ps_ += sx[i]; } lrun += ps_; pa = packp(sx, 0); pb = packp(sx, 1); } while (0)
#define MLA_PV(va, vc2, pa, pb) do { o0 = MFMA32(va[0], pa, o0); o1 = MFMA32(vc2[0], pa, o1); o0 = MFMA32(va[1], pb, o0); o1 = MFMA32(vc2[1], pb, o1); } while (0)
#define SB() __builtin_amdgcn_sched_barrier(0)
    const int nit = S >> 7;
    MLA_LOAD(0); MLA_STORE(0); __syncthreads();
    for (int it = 0; it < nit; ++it) {
        const unsigned char* sl = lds + (it & 1) * MLA_SLOT;
        MLA_LOAD(min(it + 1, nit - 1)); SB();
        if constexpr (FAST) {
            bf16x8 kaA[6], kaB[6], vaA[2], vcA[2], vaB[2], vcB[2], paA, pbA, paB, pbB; f32x16 sA, sB;
            MLA_KL(kaA, 0); MLA_KL(kaB, 1);
            MLA_QK(sA, kaA);
            MLA_QK(sB, kaB); MLA_SMF(sA, paA, pbA); MLA_VL(vaA, vcA, 0); MLA_KL(kaA, 2);
            MLA_PV(vaA, vcA, paA, pbA); MLA_QK(sA, kaA); MLA_SMF(sB, paB, pbB); MLA_VL(vaB, vcB, 1); MLA_KL(kaB, 3);
            MLA_PV(vaB, vcB, paB, pbB); MLA_QK(sB, kaB); MLA_SMF(sA, paA, pbA); MLA_VL(vaA, vcA, 2);
            MLA_PV(vaA, vcA, paA, pbA); MLA_SMF(sB, paB, pbB); MLA_VL(vaB, vcB, 3);
            MLA_PV(vaB, vcB, paB, pbB);
        } else {
#pragma unroll
            for (int t = 0; t < 2; ++t) {
                bf16x8 kaA[6], kaB[6], vaA[2], vcA[2], vaB[2], vcB[2]; f32x16 s0, s1;
                MLA_KL(kaA, 2 * t); MLA_KL(kaB, 2 * t + 1); MLA_QK(s0, kaA); MLA_QK(s1, kaB); MLA_VL(vaA, vcA, 2 * t); MLA_VL(vaB, vcB, 2 * t + 1);
                float mx_ = fmaxf(vmax16(s0), vmax16(s1)); mx_ = fmaxf(mx_, shx(mx_, lane, 32));
                const float mnew_ = fmaxf(mrun, mx_), alpha_ = fexp2(mrun - mnew_); mrun = mnew_;
                const float ps_ = exp_sum16(s0, mnew_) + exp_sum16(s1, mnew_); lrun = lrun * alpha_ + ps_; o0 *= alpha_; o1 *= alpha_;
                const bf16x8 p0_ = packp(s0, 0), p1_ = packp(s0, 1), p2_ = packp(s1, 0), p3_ = packp(s1, 1);
                MLA_PV(vaA, vcA, p0_, p1_); MLA_PV(vaB, vcB, p2_, p3_);
            }
        }
        SB(); MLA_STORE((it + 1) & 1); SB();
        __syncthreads();
    }
#undef MLA_LOAD
#undef MLA_ST1
#undef MLA_STORE
#undef MLA_KL
#undef MLA_QK
#undef MLA_VL
#undef MLA_SMF
#undef MLA_PV
#undef SB
    const float l = lrun + shx(lrun, lane, 32), inv = 1.f / l;
    const bool bad = !(l > 1e-30f && l < 1e30f) || (PROBE == 20 && FAST);
    bf16_t* op = BB + tokq * 1536 + head * 64 + 4 * h;
#pragma unroll
    for (int g4 = 0; g4 < 4; ++g4) { u32x2 w; w.x = cvtpk(o0[4 * g4] * inv, o0[4 * g4 + 1] * inv); w.y = cvtpk(o0[4 * g4 + 2] * inv, o0[4 * g4 + 3] * inv); *(u32x2*)(op + 8 * g4) = w;
        u32x2 w2; w2.x = cvtpk(o1[4 * g4] * inv, o1[4 * g4 + 1] * inv); w2.y = cvtpk(o1[4 * g4 + 2] * inv, o1[4 * g4 + 3] * inv); *(u32x2*)(op + 32 + 8 * g4) = w2; }
    return bad;
}

DI void dil_wave(unsigned char* ws, int wt, int S, int sshift, int lane) {
    const bf16_t* QD = (const bf16_t*)(ws + WS_QD); const bf16_t* KD = (const bf16_t*)(ws + WS_KD); const bf16_t* VDT = (const bf16_t*)(ws + WS_VDT); bf16_t* OG = (bf16_t*)(ws + WS_OG); float* LSE = (float*)(ws + WS_LSE);
    const int r = lane & 31, h = lane >> 5;
    const int tps = S >> 5;
    const int wtile = wt % tps, sh = wt / tps, hh = sh % 12, seq = sh / 12;
    const int g = hh >> 2, ds = 2 * g, L = S >> ds, tpr = L >> 5;
    const int res = wtile / tpr, mq0 = (wtile - res * tpr) * 32;
    const size_t tokq = (size_t)seq * S + ((size_t)(mq0 + r) << ds) + res;
    const bf16_t* qp = QD + tokq * 1536 + hh * 128 + 8 * h;
    bf16x8 qf[8];
#pragma unroll
    for (int s = 0; s < 8; ++s) qf[s] = *(const bf16x8*)(qp + 16 * s);
    f32x16 o0 = zero16(), o1 = zero16(), o2 = zero16(), o3 = zero16(); float mrun = -1e30f, lrun = 0.f;
    const bf16_t* vrow = VDT + ((size_t)((seq * 12 + hh) * 128 + r)) * S + (size_t)res * L + 4 * h;
#pragma unroll
    for (int j = 0; j < 5; ++j) {
        const int mk0 = mq0 - 64 + 32 * j;
        if (mk0 < 0 || mk0 >= L) continue;
        const bf16_t* kp = KD + ((size_t)seq * S + ((size_t)(mk0 + r) << ds) + res) * 1536 + hh * 128 + 8 * h;
        f32x16 sc = zero16();
#pragma unroll
        for (int s = 0; s < 8; ++s) { const bf16x8 kf = *(const bf16x8*)(kp + 16 * s); sc = MFMA32(kf, qf[s], sc); }
        if (j == 0 || j == 4) {
#pragma unroll
            for (int i = 0; i < 16; ++i) { const int kr = (i & 3) + 8 * (i >> 2) + 4 * h; const bool ok = (j == 0) ? (kr >= r) : (kr <= r); sc[i] = ok ? sc[i] : -1e30f; }
        }
        float mx = vmax16(sc); mx = fmaxf(mx, shx(mx, lane, 32));
        const float mnew = fmaxf(mrun, mx), alpha = fexp2(mrun - mnew); mrun = mnew;
        const float ps = exp_sum16(sc, mnew);
        lrun = lrun * alpha + ps; o0 *= alpha; o1 *= alpha; o2 *= alpha; o3 *= alpha;
#pragma unroll
        for (int s2 = 0; s2 < 2; ++s2) { const bf16x8 pf = packp(sc, s2); const bf16_t* vp = vrow + mk0 + 16 * s2;
            const bf16x8 v0 = cat44(*(const s16x4*)vp, *(const s16x4*)(vp + 8)); const bf16x8 v1 = cat44(*(const s16x4*)(vp + (size_t)32 * S), *(const s16x4*)(vp + (size_t)32 * S + 8));
            const bf16x8 v2 = cat44(*(const s16x4*)(vp + (size_t)64 * S), *(const s16x4*)(vp + (size_t)64 * S + 8)); const bf16x8 v3 = cat44(*(const s16x4*)(vp + (size_t)96 * S), *(const s16x4*)(vp + (size_t)96 * S + 8));
            o0 = MFMA32(v0, pf, o0); o1 = MFMA32(v1, pf, o1); o2 = MFMA32(v2, pf, o2); o3 = MFMA32(v3, pf, o3); }
    }
    const float l = lrun + shx(lrun, lane, 32), inv = 1.f / l;
    const size_t tl = tokq;
    bf16_t* op = OG + ((size_t)g * TCH + tl) * 512 + (hh & 3) * 128 + 4 * h;
#pragma unroll
    for (int g4 = 0; g4 < 4; ++g4) {
        u32x2 w; w.x = cvtpk(o0[4 * g4] * inv, o0[4 * g4 + 1] * inv); w.y = cvtpk(o0[4 * g4 + 2] * inv, o0[4 * g4 + 3] * inv); *(u32x2*)(op + 8 * g4) = w;
        w.x = cvtpk(o1[4 * g4] * inv, o1[4 * g4 + 1] * inv); w.y = cvtpk(o1[4 * g4 + 2] * inv, o1[4 * g4 + 3] * inv); *(u32x2*)(op + 32 + 8 * g4) = w;
        w.x = cvtpk(o2[4 * g4] * inv, o2[4 * g4 + 1] * inv); w.y = cvtpk(o2[4 * g4 + 2] * inv, o2[4 * g4 + 3] * inv); *(u32x2*)(op + 64 + 8 * g4) = w;
        w.x = cvtpk(o3[4 * g4] * inv, o3[4 * g4 + 1] * inv); w.y = cvtpk(o3[4 * g4 + 2] * inv, o3[4 * g4 + 3] * inv); *(u32x2*)(op + 96 + 8 * g4) = w; }
    if (h == 0) LSE[((size_t)g * TCH + tl) * 4 + (hh & 3)] = mrun + __builtin_amdgcn_logf(l);
}

constexpr int DL_KP = 272, DL_VP = 776;
DI void dil_phase(unsigned char* lds, unsigned char* ws, int S, int sshift, int vcu, int G, int tid, int wave, int lane) {
    const bf16_t* QD = (const bf16_t*)(ws + WS_QD); const bf16_t* KD = (const bf16_t*)(ws + WS_KD); const bf16_t* VDT = (const bf16_t*)(ws + WS_VDT); bf16_t* OG = (bf16_t*)(ws + WS_OG); float* LSE = (float*)(ws + WS_LSE);
    const int r = lane & 31, h = lane >> 5;
    const int nunits = (TCH >> 8) * 12, upt = S >> 8;
    u32x4 st[12];
#define DL_DECODE(u) const int t256_ = (u) & (upt - 1), sh_ = (u) >> (sshift - 8), hh = sh_ % 12, seq = sh_ / 12, g = hh >> 2, ds = 2 * g, L = S >> ds, tsh_ = sshift - ds - 8, res = t256_ >> tsh_, m0 = (t256_ & ((1 << tsh_) - 1)) << 8
    const int kr_ = tid >> 4, kc_ = tid & 15, vr_ = tid >> 2, vq_ = tid & 3;
    unsigned char* const kst_ = lds + kr_ * DL_KP + kc_ * 16; (void)vr_; (void)vq_;
#define DL_KLOAD(u) do { DL_DECODE(u); const bf16_t* kg_ = KD + ((size_t)seq * S + res) * 1536 + hh * 128 + kc_ * 8; _Pragma("unroll") for (int i = 0; i < 12; ++i) { int m_ = m0 - 64 + kr_ + 32 * i; m_ = m_ < 0 ? 0 : (m_ >= L ? L - 1 : m_); \
        st[i] = *(const u32x4*)(kg_ + ((size_t)m_ << ds) * 1536); } } while (0)
#define DL_KSTORE() do { _Pragma("unroll") for (int i = 0; i < 12; ++i) *(u32x4*)(kst_ + i * (32 * DL_KP)) = st[i]; } while (0)
#define DL_VLOAD(u) do { DL_DECODE(u); const bf16_t* vg_ = VDT + ((size_t)seq * S + res) * 1536 + hh * 128 + kc_ * 8; _Pragma("unroll") for (int i = 0; i < 12; ++i) { int m_ = m0 - 64 + kr_ + 32 * i; m_ = m_ < 0 ? 0 : (m_ >= L ? L - 1 : m_); \
        st[i] = *(const u32x4*)(vg_ + ((size_t)m_ << ds) * 1536); } } while (0)
#define DL_VSTORE() do { _Pragma("unroll") for (int i = 0; i < 12; ++i) *(u32x4*)(vsw_ + i * (32 * 256)) = st[i]; } while (0)
    unsigned char* const vsw_ = lds + kr_ * 256 + ((kc_ ^ ((kr_ & 3) << 2)) << 4);
    typedef short v4i16_t __attribute__((ext_vector_type(4)));
    LASQ unsigned char* const l3_ = (LASQ unsigned char*)lds;
    const int i16_ = lane & 15, tq_ = i16_ >> 2, tp_ = i16_ & 3, tblk_ = (lane >> 4) & 1;
    int u = vcu;
    if (u < nunits) { DL_KLOAD(u); DL_KSTORE(); }
    __syncthreads();
    for (; u < nunits; u += G) {
        DL_DECODE(u);
        DL_VLOAD(u);
        const int mq0 = m0 + 32 * wave;
        const size_t tokq = (size_t)seq * S + ((size_t)(mq0 + r) << ds) + res;
        const bf16_t* qp = QD + tokq * 1536 + hh * 128 + 8 * h;
        bf16x8 qf[8];
#pragma unroll
        for (int s = 0; s < 8; ++s) qf[s] = *(const bf16x8*)(qp + 16 * s);
        f32x16 sc[5]; float mx = -1e30f;
#pragma unroll
        for (int j = 0; j < 5; ++j) {
            const int mk0 = mq0 - 64 + 32 * j;
            sc[j] = zero16();
            if (mk0 >= 0 && mk0 < L) {
                const unsigned char* kb = lds + (32 * wave + 32 * j + r) * DL_KP + 16 * h;
                bf16x8 kf[4];
#pragma unroll
                for (int s = 0; s < 4; ++s) kf[s] = *(const bf16x8*)(kb + 32 * s);
#pragma unroll
                for (int s = 0; s < 4; ++s) sc[j] = MFMA32(kf[s], qf[s], sc[j]);
#pragma unroll
                for (int s = 0; s < 4; ++s) kf[s] = *(const bf16x8*)(kb + 128 + 32 * s);
#pragma unroll
                for (int s = 0; s < 4; ++s) sc[j] = MFMA32(kf[s], qf[4 + s], sc[j]);
                if (j == 0 || j == 4) {
#pragma unroll
                    for (int i = 0; i < 16; ++i) { const int kr = (i & 3) + 8 * (i >> 2) + 4 * h; const bool ok = (j == 0) ? (kr >= r) : (kr <= r); sc[j][i] = ok ? sc[j][i] : -1e30f; }
                }
                mx = fmaxf(mx, vmax16(sc[j]));
            } else {
#pragma unroll
                for (int i = 0; i < 16; ++i) sc[j][i] = -1e30f;
            }
        }
        mx = fmaxf(mx, shx(mx, lane, 32));
        float lsum = 0.f;
#pragma unroll
        for (int j = 0; j < 5; ++j) lsum += exp_sum16(sc[j], mx);
        lsum += shx(lsum, lane, 32);
        bf16x8 pfr[5][2];
#pragma unroll
        for (int j = 0; j < 5; ++j) { pfr[j][0] = packp(sc[j], 0); pfr[j][1] = packp(sc[j], 1); }
        __syncthreads();
        DL_VSTORE();
        __syncthreads();
        const int un = u + G;
        if (un < nunits) DL_KLOAD(un);
        f32x16 o0 = zero16(), o1 = zero16(), o2 = zero16(), o3 = zero16();
#pragma unroll
        for (int j = 0; j < 5; ++j) {
            const int mk0 = mq0 - 64 + 32 * j;
            if (mk0 >= 0 && mk0 < L) {
#pragma unroll
                for (int s2 = 0; s2 < 2; ++s2) { const bf16x8 pf = pfr[j][s2];
                    const int row_ = 32 * wave + 32 * j + 16 * s2 + 4 * h + tq_;
                    const int rb_ = row_ * 256 + (tp_ & 1) * 8, pc_ = 2 * tblk_ + (tp_ >> 1), sw_ = tq_ << 2;
#define DL_TR(dvb, hi) __builtin_bit_cast(s16x4, __builtin_amdgcn_ds_read_tr16_b64_v4i16((LASQ v4i16_t*)(l3_ + rb_ + (hi) * (8 * 256) + (((4 * (dvb) + pc_) ^ sw_) << 4))))
                    const bf16x8 v0 = cat44(DL_TR(0, 0), DL_TR(0, 1)); const bf16x8 v1 = cat44(DL_TR(1, 0), DL_TR(1, 1));
                    const bf16x8 v2 = cat44(DL_TR(2, 0), DL_TR(2, 1)); const bf16x8 v3 = cat44(DL_TR(3, 0), DL_TR(3, 1));
#undef DL_TR
                    o0 = MFMA32(v0, pf, o0); o1 = MFMA32(v1, pf, o1); o2 = MFMA32(v2, pf, o2); o3 = MFMA32(v3, pf, o3); }
            }
        }
        const float inv = 1.f / lsum;
        bf16_t* op = OG + ((size_t)g * TCH + tokq) * 512 + (hh & 3) * 128 + 4 * h;
#pragma unroll
        for (int g4 = 0; g4 < 4; ++g4) {
            u32x2 w; w.x = cvtpk(o0[4 * g4] * inv, o0[4 * g4 + 1] * inv); w.y = cvtpk(o0[4 * g4 + 2] * inv, o0[4 * g4 + 3] * inv); *(u32x2*)(op + 8 * g4) = w;
            w.x = cvtpk(o1[4 * g4] * inv, o1[4 * g4 + 1] * inv); w.y = cvtpk(o1[4 * g4 + 2] * inv, o1[4 * g4 + 3] * inv); *(u32x2*)(op + 32 + 8 * g4) = w;
            w.x = cvtpk(o2[4 * g4] * inv, o2[4 * g4 + 1] * inv); w.y = cvtpk(o2[4 * g4 + 2] * inv, o2[4 * g4 + 3] * inv); *(u32x2*)(op + 64 + 8 * g4) = w;
            w.x = cvtpk(o3[4 * g4] * inv, o3[4 * g4 + 1] * inv); w.y = cvtpk(o3[4 * g4 + 2] * inv, o3[4 * g4 + 3] * inv); *(u32x2*)(op + 96 + 8 * g4) = w; }
        if (h == 0) LSE[((size_t)g * TCH + tokq) * 4 + (hh & 3)] = mx + __builtin_amdgcn_logf(lsum);
        __syncthreads();
        if (un < nunits) DL_KSTORE();
        __syncthreads();
    }
#undef DL_DECODE
#undef DL_KLOAD
#undef DL_KSTORE
#undef DL_VLOAD
#undef DL_VSTORE
}

constexpr int LDS_MISC = 131072, LDS_RSTD = 131072 + 64, LDS_RSTD_ROWS = 2048, LDS_BYTES = LDS_RSTD + LDS_RSTD_ROWS * 4;
constexpr int NPHASE = 1 + (NCHUNK - 1) + NCHUNK * NLAYER * 7 + 1;
struct Args { const float* in[19]; float* out; unsigned char* ws; int ph_lo, ph_hi; };


#define XB_TMO      128
#define XB_XCNT(j)  (256  + 64 * (j))
#define XB_XSUB(j)  (1280 + 64 * (j))
#define XB_XGEN(j)  (2304 + 64 * (j))
#define XB_TOP      3328
#define XB_TOPGEN   3392
#define XCD_BAR_WORDS 3456
#define XB_SPIN_CAP (1u << 20)
DI unsigned xb_ld(unsigned* p)              { return __hip_atomic_load(p, __ATOMIC_RELAXED, __HIP_MEMORY_SCOPE_AGENT); }
DI unsigned xb_add(unsigned* p, unsigned v) { return __hip_atomic_fetch_add(p, v, __ATOMIC_RELAXED, __HIP_MEMORY_SCOPE_AGENT); }
DI unsigned xb_xcc_id() { return (unsigned)__builtin_amdgcn_s_getreg((3 << 11) | 20) & 0xFu; }
#define XB_SPIN(cond, bar) do { unsigned _sp = 0; while (cond) { __builtin_amdgcn_s_sleep(1); \
    if ((++_sp & 255u) == 0u) { if (xb_ld(&(bar)[XB_TMO])) break; if (_sp > XB_SPIN_CAP) { atomicAdd(&(bar)[XB_TMO], 1u); break; } } } } while (0)
DI void xcd_barrier_complete(unsigned* bar, unsigned x, unsigned& nloc, unsigned& nx) {
    const unsigned G = gridDim.x * gridDim.y * gridDim.z;
    unsigned sum, cnt, mine, sp = 0u;
    for (;;) {
        sum = 0u; cnt = 0u; mine = 0u;
#pragma unroll
        for (unsigned j = 0; j < 16; ++j) { const unsigned c = xb_ld(&bar[XB_XCNT(j)]); sum += c; cnt += (c > 0u) ? 1u : 0u; mine = (j == x) ? c : mine; }
        if (sum == G) break;
        __builtin_amdgcn_s_sleep(1);
        if ((++sp & 255u) == 0u) { if (xb_ld(&bar[XB_TMO])) break; if (sp > XB_SPIN_CAP) { atomicAdd(&bar[XB_TMO], 1u); break; } }
    }
    nloc = mine > 0u ? mine : 1u; nx = cnt > 0u ? cnt : 1u;
}
DI void xcd_barrier(unsigned* bar, volatile LASQ unsigned* st, const bool leader) {
    asm volatile("s_waitcnt vmcnt(0)" ::: "memory");
    __syncthreads();
    if (leader) {
        const unsigned x = xb_xcc_id();
        __builtin_amdgcn_s_waitcnt(0);
        unsigned nloc = st[0], nx = st[1];
        if (nloc == 0u) { xcd_barrier_complete(bar, x, nloc, nx); st[0] = nloc; st[1] = nx; }
        const unsigned old = xb_add(&bar[XB_XSUB(x)], 1u);
        const unsigned gen = old / nloc;
        if (old + 1u == (gen + 1u) * nloc) {
            __builtin_amdgcn_fence(__ATOMIC_RELEASE, "agent");
            asm volatile("s_waitcnt vmcnt(0)" ::: "memory");
            const unsigned og = xb_add(&bar[XB_TOP], 1u);
            const unsigned tg = og / nx;
            if (og + 1u == (tg + 1u) * nx) xb_add(&bar[XB_TOPGEN], 1u);
            else XB_SPIN(xb_ld(&bar[XB_TOPGEN]) == tg, bar);
            __builtin_amdgcn_fence(__ATOMIC_ACQUIRE, "agent");
            xb_add(&bar[XB_XGEN(x)], 1u);
            asm volatile("s_waitcnt vmcnt(0)" ::: "memory");
        } else {
            XB_SPIN(xb_ld(&bar[XB_XGEN(x)]) == gen, bar);
            __builtin_amdgcn_fence(__ATOMIC_ACQUIRE, "agent");
            asm volatile("s_waitcnt vmcnt(0)" ::: "memory");
        }
    }
    __syncthreads();
}

struct EpiP { int S, sshift, flag; unsigned char* ws; const float* xin; float* xout; };
template <int MODE> DI void run_gemm(unsigned char* lds, const bf16_t* A, int lda, const bf16_t* Bt, int N, int K, int G, int c, const EpiP& P, const int tid) {
    int tid_l = tid; asm volatile("" : "+v"(tid_l)); asm volatile("" : "+s"(K), "+s"(lda), "+s"(N));
    pg8::Gemm g{A, Bt, TCH, N, K, lda}; pg8::StaticOrder S; S.init(TCH, N, G, c, MODE == pg8::EM_INPROJ ? WGM_IN : (MODE == pg8::EM_FF1 ? WGM_FF : 4));
    pg8::EpiAll<MODE> E; E.S = P.S; E.sshift = P.sshift; E.flag = P.flag; E.ws = P.ws; E.xin = P.xin; E.xout = P.xout;
    E.rs_lds = (const LASQ float*)(lds + LDS_RSTD); E.rs_base = 0; E.rs_on = 0;
    if constexpr (MODE == pg8::EM_INPROJ || MODE == pg8::EM_Q || MODE == pg8::EM_K || MODE == pg8::EM_FF1) {
        int pmin = 1 << 30, pmax = -1; { pg8::Unit u_; for (int i = 0; S.next(i, u_); ++i) { pmin = u_.pm < pmin ? u_.pm : pmin; pmax = u_.pm > pmax ? u_.pm : pmax; } }
        const int nrow = pmax >= pmin ? (pmax - pmin + 1) * 256 : 0;
        if (nrow > 0 && nrow <= LDS_RSTD_ROWS) {
            const sq_t* sq = (const sq_t*)(P.ws + WS_STAT) + (MODE == pg8::EM_INPROJ ? 0 : (MODE == pg8::EM_FF1 ? TCH : (MODE == pg8::EM_Q ? 2 * TCH : 3 * TCH)));
            const float invn = MODE == pg8::EM_Q ? 1.f / 384.f : (MODE == pg8::EM_K ? 1.f / 256.f : 1.f / 1024.f);
            LASQ float* rl = (LASQ float*)(lds + LDS_RSTD);
            for (int r_ = tid_l; r_ < nrow; r_ += 512) rl[r_] = 1.f / sqrtf((float)sq[pmin * 256 + r_] * (invn * (1.f / 16777216.f)) + RMS_EPS);
            __syncthreads();
            E.rs_base = pmin * 256; E.rs_on = 1;
        }
    }
    pg8::gemm_phase<pg8::EpiAll<MODE>, pg8::StaticOrder, true, true>((PG8_LAS unsigned char*)lds, g, S, E, tid_l);
}

__global__ void __launch_bounds__(512, 2) fwd_megakernel(Args a) {
    extern __shared__ __attribute__((aligned(16))) unsigned char lds[];
    cg::grid_group grid = cg::this_grid();
    const int G = gridDim.x, bx = blockIdx.x, NGW = G * 8, NGT = G * 512;
    const int vcu = (G % 8 == 0) ? (bx % 8) * (G / 8) + bx / 8 : bx;
    const int lo = a.ph_lo, hi = a.ph_hi; int ph = 0, c = 0, l = 0;
    const int wave0 = __builtin_amdgcn_readfirstlane((int)threadIdx.x >> 6);
    volatile LASQ unsigned* bar_st = (volatile LASQ unsigned*)((LASQ unsigned char*)lds + LDS_MISC);
    if (threadIdx.x < 16) bar_st[threadIdx.x] = 0u;
    __syncthreads();
    if (threadIdx.x == 0) (void)xb_add((unsigned*)(a.ws + WS_BAR) + XB_XCNT(xb_xcc_id()), 1u);
    typedef const __attribute__((address_space(4))) Args* KArgP;
#define PH_BEGIN if (ph >= lo && ph < hi) { const int lane = fresh_lane(); int wave_ = wave0; asm volatile("" : "+s"(wave_)); const int wave = wave_, tid = wave_ * 64 + lane; int c_ = c, l_ = l; asm volatile("" : "+s"(c_), "+s"(l_)); \
        KArgP ap = (KArgP)__builtin_amdgcn_kernarg_segment_ptr(); asm volatile("" : "+s"(ap)); \
        const int gw = vcu * 8 + wave, gtid = bx * 512 + tid; (void)lane; (void)gw; (void)gtid; \
        unsigned char* ws = ap->ws; const int S = c_ < 4 ? 4096 : 8192, sshift = c_ < 4 ? 12 : 13; (void)sshift; \
        const float* xin = c_ < 4 ? ap->in[0] + (size_t)c_ * TCH * 1024 : ap->in[1]; float* xo = ap->out + (size_t)c_ * TCH * 1024; \
        unsigned char* wl = ws + (size_t)l_ * W_LAYER; (void)wl; const float* xcur = l_ == 0 ? xin : xo; \
        sq_t* SQ = (sq_t*)(ws + WS_STAT); (void)SQ; EpiP E; E.S = S; E.sshift = sshift; E.flag = 0; E.ws = ws; E.xin = xcur; E.xout = xo;
#define PH_END } ++ph; if (ph > lo && ph < hi) { if (ph == 1) grid.sync(); else { xcd_barrier((unsigned*)(a.ws + WS_BAR), bar_st, wave0 == 0 && fresh_lane() == 0); if (PROBE == 10) xcd_barrier((unsigned*)(a.ws + WS_BAR), bar_st, wave0 == 0 && fresh_lane() == 0); } }

    PH_BEGIN
        for (int rep_ = 0; rep_ < (PROBE == 11 ? 2 : 1); ++rep_) {
#pragma nounroll
        for (int ll = 0; ll < NLAYER; ++ll) { unsigned char* wq = ws + (size_t)ll * W_LAYER;
            conv_items<1>(ap->in[3] + (size_t)ll * 1024 * INW, 1024, INW, (bf16_t*)(wq + W_IN), INP, gtid, NGT, 0, 0, ap->in[2] + ll * 1024);
            conv_items<0>(ap->in[16] + (size_t)ll * 1024 * 4096, 1024, 4096, (bf16_t*)(wq + W_FF1), 4096, gtid, NGT, 0, 0, ap->in[15] + ll * 1024);
            conv_items<0>(ap->in[17] + (size_t)ll * 4096 * 1024, 4096, 1024, (bf16_t*)(wq + W_FF2), 1024, gtid, NGT);
            conv_items<0>(ap->in[14] + (size_t)ll * 1024 * 1024, 1024, 1024, (bf16_t*)(wq + W_O), 1024, gtid, NGT);
            conv_items<0>(ap->in[12] + (size_t)ll * 512 * 1024, 512, 1024, (bf16_t*)(wq + W_A), 1024, gtid, NGT, 1536, 512);
            conv_items<0>(ap->in[13] + (size_t)ll * 512 * 1024, 512, 1024, (bf16_t*)(wq + W_A), 1024, gtid, NGT, 1536, 1024);
            conv_items<2>(ap->in[8] + (size_t)ll * 384 * 768, 384, 768, (bf16_t*)(wq + W_UQ), 768, gtid, NGT, 0, 0, ap->in[6] + ll * 384);
            conv_items<0>(ap->in[9] + (size_t)ll * 256 * 512, 256, 512, (bf16_t*)(wq + W_UK), 512, gtid, NGT, 0, 0, ap->in[7] + ll * 256);
            conv_items<0>(ap->in[10] + (size_t)ll * 256 * 512, 256, 512, (bf16_t*)(wq + W_UV), 512, gtid, NGT, 0, 0, ap->in[7] + ll * 256);
            conv_weff(ap->in[4] + (size_t)ll * 4 * 128 * 128, ap->in[5] + (size_t)ll * 512, ap->in[11] + (size_t)ll * 512 * 1024, (bf16_t*)(wq + W_A), gtid, NGT); }
        rope_table((float*)(ws + WS_CS128), 64, 0.8659643233600653, gtid, NGT);
        rope_table((float*)(ws + WS_CS32), 16, 0.5623413251903491, gtid, NGT); }
        p0_rows(ap->in[0], (bf16_t*)(ws + WS_H), SQ, TCH, gw, NGW, lane);
        zero_sq(SQ + 2 * TCH, 2 * TCH, gtid, NGT);
    PH_END

#pragma nounroll
    for (c = 0; c < NCHUNK; ++c) {
#pragma nounroll
        for (l = 0; l < NLAYER; ++l) {
            if (l == 0 && c > 0) {
            PH_BEGIN
                final_rows((const bf16_t*)(ws + WS_MRG), SQ + 4 * TCH, ap->in[18], ap->out + (size_t)(c_ - 1) * TCH * 1024, TCH, gw, NGW, lane);
                p0_rows(xin, (bf16_t*)(ws + WS_H), SQ, TCH, gw, NGW, lane);
                zero_sq(SQ + 2 * TCH, 2 * TCH, gtid, NGT);
            PH_END
            }
            PH_BEGIN zero_sq(SQ + TCH, TCH, gtid, NGT);
                if (STAGGER && (bx & 8)) { for (int q_ = 0; q_ < STAGGER; ++q_) __builtin_amdgcn_s_sleep(127); }
                for (int rep_ = 0; rep_ < (PROBE == 1 ? 2 : 1); ++rep_) run_gemm<pg8::EM_INPROJ>(lds, (const bf16_t*)(ws + WS_H), 1024, (const bf16_t*)(wl + W_IN), INP, 1024, G, bx, E, tid); PH_END
            PH_BEGIN
                zero_sq(l_ == 0 ? SQ : SQ + 4 * TCH, TCH, gtid, NGT);
                pool_rows(ws, S, gw, NGW, lane);
#ifndef NO_DIL
                for (int rep_ = 0; rep_ < (PROBE == 2 ? 2 : 1); ++rep_) dil_phase(lds, ws, S, sshift, vcu, G, tid, wave, lane);
#endif
                const int rotk = G >= 192 ? (bx >= 192 ? bx - 192 : bx + G - 192) : bx;
                run_gemm<pg8::EM_Q>(lds, (const bf16_t*)(ws + WS_CQ), 768, (const bf16_t*)(wl + W_UQ), 768, 384, G, bx, E, tid);
                run_gemm<pg8::EM_K>(lds, (const bf16_t*)(ws + WS_CQ) + 384, 768, (const bf16_t*)(wl + W_UK), 1024, 256, G, rotk, E, tid);
            PH_END
            PH_BEGIN
                zero_sq(SQ + 2 * TCH, 2 * TCH, gtid, NGT);
                t2_rows(ws, gw, NGW, lane);
#ifndef NO_MLA
                { const int nqb = S >> 8, nunits = (TCH >> 8) * 8;
                  for (int rep_ = 0; rep_ < (PROBE == 4 ? 2 : 1); ++rep_) for (int u = vcu; u < nunits; u += G) { const int qb = u & (nqb - 1), hs = u >> (sshift - 8), head = hs & 7, seq = hs >> 3; if (tid == 0) bar_st[4] = 0u;
                      const bool bad = mla_unit<true>(lds, ws, seq, head, qb, S, tid, wave, lane); if (bad) bar_st[4] = 1u; __syncthreads(); const unsigned redo = bar_st[4]; __syncthreads();
                      if (redo) (void)mla_unit<false>(lds, ws, seq, head, qb, S, tid, wave, lane); } }
#endif
            PH_END
            PH_BEGIN
                for (int rep_ = 0; rep_ < (PROBE == 13 ? 2 : 1); ++rep_) run_gemm<pg8::EM_MRG>(lds, (const bf16_t*)(ws + WS_BR), 1536, (const bf16_t*)(wl + W_A), 1024, 1536, G, bx, E, tid);
            PH_END
            PH_BEGIN
                run_gemm<pg8::EM_WO>(lds, (const bf16_t*)(ws + WS_MRG), 1024, (const bf16_t*)(wl + W_O), 1024, 1024, G, bx, E, tid); PH_END
            PH_BEGIN for (int rep_ = 0; rep_ < (PROBE == 8 ? 2 : 1); ++rep_) run_gemm<pg8::EM_FF1>(lds, (const bf16_t*)(ws + WS_H), 1024, (const bf16_t*)(wl + W_FF1), 4096, 1024, G, bx, E, tid); PH_END
            PH_BEGIN E.flag = (l_ == NLAYER - 1);
                run_gemm<pg8::EM_FF2>(lds, (const bf16_t*)(ws + WS_FF), 4096, (const bf16_t*)(wl + W_FF2), 1024, 4096, G, bx, E, tid); PH_END
        }
    }
    c = NCHUNK - 1; l = 0;
    PH_BEGIN final_rows((const bf16_t*)(ws + WS_MRG), SQ + 4 * TCH, ap->in[18], ap->out + (size_t)(NCHUNK - 1) * TCH * 1024, TCH, gw, NGW, lane); PH_END
#undef PH_BEGIN
#undef PH_END
}

extern "C" void kernel_launch(void* const* d_in, const int* in_sizes, int n_in, void* d_out, int out_size, void* d_ws, size_t ws_size, hipStream_t stream) {
    static int grid = 0;
    if (grid == 0) {
        if (n_in != 19 || ws_size < WS_END || out_size != NCHUNK * TCH * 1024) { fprintf(stderr, "kernel_launch: unexpected shapes (n_in %d, out %d, ws %zu)\n", n_in, out_size, ws_size); grid = -1; return; }
        int dev = 0, cus = 0, per_cu = 0;
        if (hipGetDevice(&dev) != hipSuccess || hipDeviceGetAttribute(&cus, hipDeviceAttributeMultiprocessorCount, dev) != hipSuccess) { grid = -1; return; }
        if (hipFuncSetAttribute((const void*)fwd_megakernel, hipFuncAttributeMaxDynamicSharedMemorySize, LDS_BYTES) != hipSuccess) { fprintf(stderr, "kernel_launch: hipFuncSetAttribute failed\n"); grid = -1; return; }
        if (hipOccupancyMaxActiveBlocksPerMultiprocessor(&per_cu, (const void*)fwd_megakernel, 512, LDS_BYTES) != hipSuccess || per_cu < 1) { fprintf(stderr, "kernel_launch: occupancy query says %d\n", per_cu); per_cu = 1; }
        (void)hipGetLastError();
        grid = cus * 1;
    }
    if (grid < 0) return;
    if (hipMemsetAsync((char*)d_ws + WS_BAR, 0, XCD_BAR_WORDS * 4, stream) != hipSuccess) { fprintf(stderr, "kernel_launch: memset failed\n"); return; }
    Args a{};
    for (int i = 0; i < 19; ++i) a.in[i] = (const float*)d_in[i];
    a.out = (float*)d_out; a.ws = (unsigned char*)d_ws;
#if COOP
    a.ph_lo = 0; a.ph_hi = NPHASE;
    void* args[] = {&a};
    hipError_t e = hipLaunchCooperativeKernel((const void*)fwd_megakernel, dim3(grid), dim3(512), args, LDS_BYTES, stream);
    if (e != hipSuccess) fprintf(stderr, "cooperative launch failed: %s (grid %d)\n", hipGetErrorString(e), grid);
#else
    for (int p = 0; p < NPHASE; ++p) { a.ph_lo = p; a.ph_hi = p + 1; hipLaunchKernelGGL(fwd_megakernel, dim3(grid), dim3(512), LDS_BYTES, stream, a); }
#endif
}
```

```cpp
#include <hip/hip_runtime.h>
#include <hip/hip_cooperative_groups.h>
#include <cstdio>
#include <cstdint>
namespace cg = cooperative_groups;

#ifndef COOP
#define COOP 1
#endif
#ifndef PROBE
#define PROBE 0
#endif
#ifndef STAGGER
#define STAGGER 0
#endif
#ifndef WGM_IN
#define WGM_IN 4
#endif
#ifndef WGM_FF
#define WGM_FF 4
#endif

constexpr int DM = 1024, TCH = 16384, NCHUNK = 5, NLAYER = 2, INW = 8864, INP = 8960, DFF = 4096;
constexpr float RMS_EPS = 1e-6f;
constexpr float QSC_MLA = 0.14724444602590306f;
constexpr float QSC_DIL = 0.12751743082459868f;
constexpr size_t MiB = (size_t)1 << 20;
constexpr size_t W_IN = 0, W_FF1 = W_IN + (size_t)INP * 1024 * 2, W_FF2 = W_FF1 + (size_t)4096 * 1024 * 2, W_O = W_FF2 + (size_t)4096 * 1024 * 2, W_A = W_O + (size_t)1024 * 1024 * 2,
                 W_B = W_A + (size_t)1024 * 512 * 2, W_C = W_B + (size_t)1024 * 512 * 2, W_UQ = W_C + (size_t)1024 * 512 * 2, W_UK = W_UQ + (size_t)768 * 384 * 2, W_UV = W_UK + (size_t)512 * 256 * 2,
                 W_LAYER = W_UV + (size_t)512 * 256 * 2;
static_assert(2 * W_LAYER <= 80 * MiB, "weights");
constexpr size_t WS_CS128 = 80 * MiB, WS_CS32 = 84 * MiB, WS_H = 86 * MiB, WS_UP = 118 * MiB, WS_CQ = 134 * MiB, WS_QD = 158 * MiB, WS_KD = 206 * MiB, WS_VDT = 254 * MiB,
                 WS_GATES = 302 * MiB, WS_MIX = 398 * MiB, WS_Q = 414 * MiB, WS_K = 438 * MiB, WS_VT = 462 * MiB, WS_OG = 478 * MiB, WS_LSE = 526 * MiB, WS_CB = 527 * MiB,
                 WS_BB = 543 * MiB, WS_TMP = 559 * MiB, WS_MRG = 623 * MiB, WS_FF = 655 * MiB, WS_BAR = 783 * MiB, WS_BR = 784 * MiB, WS_STAT = 832 * MiB, WS_END = 833 * MiB;

typedef float f32x16 __attribute__((ext_vector_type(16)));
typedef float f32x2_t __attribute__((ext_vector_type(2)));
typedef __bf16 bf16x2_t __attribute__((ext_vector_type(2)));
typedef short s16x4 __attribute__((ext_vector_type(4)));
typedef unsigned u32x2 __attribute__((ext_vector_type(2)));
#define DI __device__ __forceinline__
typedef unsigned long long sq_t;
#define LASQ __attribute__((address_space(3)))

DI unsigned cvtpk(float lo, float hi) { f32x2_t v = {lo, hi}; bf16x2_t b = __builtin_convertvector(v, bf16x2_t); return __builtin_bit_cast(unsigned, b); }
DI unsigned short f2bf(float f) { return (unsigned short)(cvtpk(f, 0.f) & 0xffffu); }
DI float bflo(unsigned u) { return __builtin_bit_cast(float, u << 16); }
DI float bfhi(unsigned u) { return __builtin_bit_cast(float, u & 0xffff0000u); }
DI float fexp2(float x) { return __builtin_amdgcn_exp2f(x); }
DI float shx(float v, int lane, int mask) { return __builtin_bit_cast(float, __builtin_amdgcn_ds_bpermute((lane ^ mask) << 2, __builtin_bit_cast(int, v))); }
DI float wave_sum(float v, int lane) {
#pragma unroll
    for (int o = 1; o < 64; o <<= 1) v += shx(v, lane, o);
    return v;
}
DI int fresh_lane() { int l; asm volatile("v_mbcnt_lo_u32_b32 %0, -1, 0\n\tv_mbcnt_hi_u32_b32 %0, -1, %0" : "=v"(l)); return l; }
namespace pg8 {
#define PG8_LAS __attribute__((address_space(3)))
typedef unsigned short bf16_t;
typedef short bf16x8 __attribute__((ext_vector_type(8)));
typedef float f32x4 __attribute__((ext_vector_type(4)));
typedef unsigned u32x4 __attribute__((ext_vector_type(4)));
constexpr int BM = 256, BK = 64, HALF = 128, HTB = HALF * BK * 2  , STAGE_BYTES = 8 * HTB, NXCD = 8, WGM = 4;

__host__ __device__ __forceinline__ int lds_byte(int r, int c) { const int st = (r >> 4) * 2 + (c >> 5), rr = r & 15, cc = c & 31, ob = rr * 64 + cc * 2; return st * 1024 + (ob ^ (((ob >> 9) & 1) << 5)); }
__host__ __device__ __forceinline__ void stage_rc(int b, int& R, int& C) { const int st = b / 1024, sb = b % 1024, swz = sb ^ (((sb >> 9) & 1) << 5); R = (st >> 1) * 16 + swz / 64; C = (st & 1) * 32 + (swz % 64) / 2; }
__host__ __device__ __forceinline__ int perm32(int rho) { const int n = rho >> 4, i = rho & 15; return 8 * (i >> 2) + 4 * n + (i & 3); }

struct Unit { int pm, pn; };
struct Gemm { const bf16_t* A; const bf16_t* Bt; int M, N, K, lda; };

struct StaticOrder {
    int nM, nN, nwg, G, c, wgm;
    __host__ __device__ void init(int M, int N, int G_, int c_, int wgm_ = WGM) { nM = M / BM; nN = N / BM; nwg = nM * nN; G = G_; c = c_; wgm = wgm_; }
    __host__ __device__ bool next(int i, Unit& u) const {
        const long L = (long)i * G + c; if (L >= nwg) return false;
        int wgid = (int)L; { const int q = nwg / NXCD, r = nwg % NXCD, xcd = wgid % NXCD, off = wgid / NXCD; wgid = (xcd < r ? xcd * (q + 1) : r * (q + 1) + (xcd - r) * q) + off; }
        const int nig = wgm * nN, gid = wgid / nig, fm = gid * wgm, gsz = (nM - fm) < wgm ? (nM - fm) : wgm;
        u.pm = fm + ((wgid % nig) % gsz); u.pn = (wgid % nig) / gsz; return true;
    }
    __device__ __forceinline__ void a_ready(const Unit&) const {}
    __device__ __forceinline__ void done(const Unit&) const {}
};

enum { EM_INPROJ = 0, EM_Q, EM_K, EM_V, EM_MRG, EM_WO, EM_FF1, EM_FF2 };
typedef unsigned u32x2e __attribute__((ext_vector_type(2)));
template <int mode> struct EpiAll {
    static constexpr bool PERM = true, AFTER_DRAIN = false, KHOOK = (mode == EM_MRG), DUP = (PROBE >= 30 && PROBE <= 36 && PROBE != 31 && mode == EM_INPROJ) || (PROBE == 31 && mode == EM_FF1);
    __device__ __forceinline__ static bool dup_tile(int pn) { return PROBE == 32 ? pn >= 23 : ((PROBE == 33 || PROBE == 36) ? (pn >= 5 && pn < 17) : (PROBE == 34 ? (pn < 2 || (pn >= 17 && pn < 23)) : (PROBE == 35 ? (pn >= 2 && pn < 5) : true))); }
    int S, sshift, flag;
    unsigned char* ws;
    const float* xin; float* xout;
    const LASQ float* rs_lds; int rs_base, rs_on;
    __device__ __forceinline__ static u32x4 pack8(const f32x4& a, const f32x4& b) { u32x4 w; w.x = cvtpk(a[0], a[1]); w.y = cvtpk(a[2], a[3]); w.z = cvtpk(b[0], b[1]); w.w = cvtpk(b[2], b[3]); return w; }
    __device__ __forceinline__ void khook(f32x4 (&acc)[2][2][4][2], const Unit& u, int t, int wr, int wc, int fr, int fq) const {
        const int br = t >> 4; const bf16_t* gates = (const bf16_t*)(ws + WS_GATES) + br * 1024;
        const int row0 = u.pm * BM + wr * 64 + fr, cw = wc * 32 + 8 * fq;
#pragma unroll
        for (int ai = 0; ai < 2; ++ai)
#pragma unroll
            for (int m = 0; m < 4; ++m) { const int row = row0 + ai * HALF + m * 16;
#pragma unroll
                for (int bj = 0; bj < 2; ++bj) { const int C0 = u.pn * 256 + bj * HALF + cw;
                    const u32x4 ga = *(const u32x4*)(gates + (size_t)row * 3072 + C0), gb = *(const u32x4*)(gates + (size_t)row * 3072 + 1024 + C0);
                    f32x4& v0 = acc[ai][bj][m][0]; f32x4& v1 = acc[ai][bj][m][1];
                    v0[0] *= bflo(ga.x) * __builtin_amdgcn_rcpf(bflo(gb.x)); v0[1] *= bfhi(ga.x) * __builtin_amdgcn_rcpf(bfhi(gb.x)); v0[2] *= bflo(ga.y) * __builtin_amdgcn_rcpf(bflo(gb.y)); v0[3] *= bfhi(ga.y) * __builtin_amdgcn_rcpf(bfhi(gb.y));
                    v1[0] *= bflo(ga.z) * __builtin_amdgcn_rcpf(bflo(gb.z)); v1[1] *= bfhi(ga.z) * __builtin_amdgcn_rcpf(bfhi(gb.z)); v1[2] *= bflo(ga.w) * __builtin_amdgcn_rcpf(bflo(gb.w)); v1[3] *= bfhi(ga.w) * __builtin_amdgcn_rcpf(bfhi(gb.w)); } }
    }
    __device__ __forceinline__ static float rstd_of(const sq_t* sq, int row, float invn) { return 1.f / sqrtf((float)sq[row] * (invn * (1.f / 16777216.f)) + RMS_EPS); }
    __device__ __forceinline__ float rstd_row(const sq_t* sq, int row, float invn) const { return rs_on ? rs_lds[row - rs_base] : rstd_of(sq, row, invn); }
    __device__ __forceinline__ static float sumsq8(const f32x4& a, const f32x4& b) { return ((a[0] * a[0] + a[1] * a[1]) + (a[2] * a[2] + a[3] * a[3])) + ((b[0] * b[0] + b[1] * b[1]) + (b[2] * b[2] + b[3] * b[3])); }
    __device__ __forceinline__ static void row_atomic(sq_t* sq, int row, float s, int lane, int fq) { s += shx(s, lane, 16); s += shx(s, lane, 32); if (fq == 0) (void)__hip_atomic_fetch_add(sq + row, (sq_t)(s * 16777216.f), __ATOMIC_RELAXED, __HIP_MEMORY_SCOPE_AGENT); }
    __device__ __forceinline__ void operator()(const f32x4 (&acc)[2][2][4][2], const Unit& u, int wr, int wc, int fr, int fq) const {
        const int row0 = u.pm * BM + wr * 64 + fr;
        const int cw = wc * 32 + 8 * fq;
        const int pn = u.pn, lane = fq * 16 + fr;
        sq_t* SQX = (sq_t*)(ws + WS_STAT); sq_t* SQMID = SQX + TCH; sq_t* SQQ = SQX + 2 * TCH; sq_t* SQKV = SQX + 3 * TCH;
        if (mode == EM_INPROJ) {
            float rs[2][4];
#pragma unroll
            for (int ai = 0; ai < 2; ++ai)
#pragma unroll
                for (int m = 0; m < 4; ++m) rs[ai][m] = rstd_row(SQX, row0 + ai * HALF + m * 16, 1.f / 1024.f);
            if (pn < 2) {
                bf16_t* base = (bf16_t*)(ws + WS_UP); const int coff = pn * 256 + cw;
#pragma unroll
                for (int ai = 0; ai < 2; ++ai)
#pragma unroll
                    for (int m = 0; m < 4; ++m) { bf16_t* rowp = base + (size_t)(row0 + ai * HALF + m * 16) * 512 + coff;
#pragma unroll
                        for (int bj = 0; bj < 2; ++bj) *(u32x4*)(rowp + bj * HALF) = pack8(acc[ai][bj][m][0] * rs[ai][m], acc[ai][bj][m][1] * rs[ai][m]); }
            } else if (pn < 5) {
                bf16_t* base = (bf16_t*)(ws + WS_CQ);
#pragma unroll
                for (int bj = 0; bj < 2; ++bj) { const int hidx = (pn - 2) * 2 + bj;
                    if (hidx < 5) { sq_t* sq = hidx < 3 ? SQQ : SQKV;
#pragma unroll
                        for (int ai = 0; ai < 2; ++ai)
#pragma unroll
                            for (int m = 0; m < 4; ++m) { const int row = row0 + ai * HALF + m * 16; const f32x4 v0 = acc[ai][bj][m][0] * rs[ai][m], v1 = acc[ai][bj][m][1] * rs[ai][m];
                                *(u32x4*)(base + (size_t)row * 768 + hidx * 128 + cw) = pack8(v0, v1); row_atomic(sq, row, sumsq8(v0, v1) * ((PROBE == 1 || PROBE == 30 || PROBE == 35) ? 0.5f : 1.f), lane, fq); }
                    } else if (wc == 0) { const float* cs = (const float*)(ws + WS_CS32); const int f0 = 4 * fq; bf16_t* kb = (bf16_t*)(ws + WS_K);
#pragma unroll
                        for (int ai = 0; ai < 2; ++ai)
#pragma unroll
                            for (int m = 0; m < 4; ++m) { const int row = row0 + ai * HALF + m * 16, pos = row & (S - 1);
                                const f32x4* cp = (const f32x4*)(cs + ((size_t)pos * 16 + f0) * 2); const f32x4 c01 = cp[0], c23 = cp[1];
                                const f32x4 v0 = acc[ai][bj][m][0] * rs[ai][m], v1 = acc[ai][bj][m][1] * rs[ai][m];
                                const float a0 = v0[0] * c01[0] - v0[1] * c01[1], b0 = v0[1] * c01[0] + v0[0] * c01[1];
                                const float a1 = v0[2] * c01[2] - v0[3] * c01[3], b1 = v0[3] * c01[2] + v0[2] * c01[3];
                                const float a2 = v1[0] * c23[0] - v1[1] * c23[1], b2 = v1[1] * c23[0] + v1[0] * c23[1];
                                const float a3 = v1[2] * c23[2] - v1[3] * c23[3], b3 = v1[3] * c23[2] + v1[2] * c23[3];
                                u32x2e w1, w2; w1.x = cvtpk(a0, a1); w1.y = cvtpk(a2, a3); w2.x = cvtpk(b0, b1); w2.y = cvtpk(b2, b3);
                                bf16_t* kp = kb + (size_t)row * 768 + 64 + f0;
#pragma unroll
                                for (int hh = 0; hh < 8; ++hh) { *(u32x2e*)(kp + hh * 96) = w1; *(u32x2e*)(kp + hh * 96 + 16) = w2; } }
                    }
                }
            } else if (pn < 17) {
                const bool isq = pn < 11; bf16_t* base = isq ? (bf16_t*)(ws + WS_QD) : (bf16_t*)(ws + WS_KD); const int hh0 = (isq ? pn - 5 : pn - 11) * 2; const float sc0 = isq ? QSC_DIL : 1.f;
                const int f0 = wc * 16 + 4 * fq; const float* cs = (const float*)(ws + WS_CS128);
#pragma unroll
                for (int ai = 0; ai < 2; ++ai)
#pragma unroll
                    for (int m = 0; m < 4; ++m) { const int row = row0 + ai * HALF + m * 16, pos = row & (S - 1); const float sc = sc0 * rs[ai][m];
                        const f32x4* cp = (const f32x4*)(cs + ((size_t)pos * 64 + f0) * 2); const f32x4 c01 = cp[0], c23 = cp[1];
#pragma unroll
                        for (int bj = 0; bj < 2; ++bj) { const f32x4 v0 = acc[ai][bj][m][0], v1 = acc[ai][bj][m][1];
                            const float a0 = (v0[0] * c01[0] - v0[1] * c01[1]) * sc, b0 = (v0[1] * c01[0] + v0[0] * c01[1]) * sc;
                            const float a1 = (v0[2] * c01[2] - v0[3] * c01[3]) * sc, b1 = (v0[3] * c01[2] + v0[2] * c01[3]) * sc;
                            const float a2 = (v1[0] * c23[0] - v1[1] * c23[1]) * sc, b2 = (v1[1] * c23[0] + v1[0] * c23[1]) * sc;
                            const float a3 = (v1[2] * c23[2] - v1[3] * c23[3]) * sc, b3 = (v1[3] * c23[2] + v1[2] * c23[3]) * sc;
                            u32x2e w1, w2; w1.x = cvtpk(a0, a1); w1.y = cvtpk(a2, a3); w2.x = cvtpk(b0, b1); w2.y = cvtpk(b2, b3);
                            const bool odd = (fq & 1) != 0; const u32x2e snd = odd ? w1 : w2; u32x2e rcv;
                            rcv.x = (unsigned)__builtin_amdgcn_ds_bpermute((lane ^ 16) << 2, (int)snd.x); rcv.y = (unsigned)__builtin_amdgcn_ds_bpermute((lane ^ 16) << 2, (int)snd.y);
                            u32x4 o; if (odd) { o.x = rcv.x; o.y = rcv.y; o.z = w2.x; o.w = w2.y; } else { o.x = w1.x; o.y = w1.y; o.z = rcv.x; o.w = rcv.y; }
                            if (!(flag & 4) || o.x == 0x12345678u) *(u32x4*)(base + (size_t)row * 1536 + (hh0 + bj) * 128 + (odd ? 64 + f0 - 4 : f0)) = o; } }
            } else if (pn < 23) {
                bf16_t* base = (bf16_t*)(ws + WS_VDT); const int coff = (pn - 17) * 256 + cw;
#pragma unroll
                for (int ai = 0; ai < 2; ++ai)
#pragma unroll
                    for (int m = 0; m < 4; ++m) { bf16_t* rowp = base + (size_t)(row0 + ai * HALF + m * 16) * 1536 + coff;
#pragma unroll
                        for (int bj = 0; bj < 2; ++bj) *(u32x4*)(rowp + bj * HALF) = pack8(acc[ai][bj][m][0] * rs[ai][m], acc[ai][bj][m][1] * rs[ai][m]); }
            } else {
                bf16_t* base = (bf16_t*)(ws + WS_GATES); const int coff = (pn - 23) * 256 + cw;
#pragma unroll
                for (int ai = 0; ai < 2; ++ai)
#pragma unroll
                    for (int m = 0; m < 4; ++m) { bf16_t* rowp = base + (size_t)(row0 + ai * HALF + m * 16) * 3072 + coff; const float ns = -1.4426950408889634f * rs[ai][m];
#pragma unroll
                        for (int bj = 0; bj < 2; ++bj) { f32x4 v0 = acc[ai][bj][m][0], v1 = acc[ai][bj][m][1];
#pragma unroll
                            for (int e = 0; e < 4; ++e) { v0[e] = __builtin_amdgcn_rcpf(1.f + fexp2(ns * v0[e])); v1[e] = __builtin_amdgcn_rcpf(1.f + fexp2(ns * v1[e])); }
                            __builtin_nontemporal_store(pack8(v0, v1), (u32x4*)(rowp + bj * HALF)); } }
            }
        } else if (mode == EM_Q) {
            bf16_t* base = (bf16_t*)(ws + WS_Q); const float* cs = (const float*)(ws + WS_CS32);
            float rs[2][4];
#pragma unroll
            for (int ai = 0; ai < 2; ++ai)
#pragma unroll
                for (int m = 0; m < 4; ++m) rs[ai][m] = rstd_row(SQQ, row0 + ai * HALF + m * 16, 1.f / 384.f) * QSC_MLA;
#pragma unroll
            for (int bj = 0; bj < 2; ++bj) { const int C0 = pn * 256 + bj * HALF + cw, head = C0 / 96, w = C0 - head * 96;
                if (w < 64) {
#pragma unroll
                    for (int ai = 0; ai < 2; ++ai)
#pragma unroll
                        for (int m = 0; m < 4; ++m) { const int row = row0 + ai * HALF + m * 16; *(u32x4*)(base + (size_t)row * 768 + C0) = pack8(acc[ai][bj][m][0] * rs[ai][m], acc[ai][bj][m][1] * rs[ai][m]); }
                } else { const int f0 = (w - 64) >> 1;
#pragma unroll
                    for (int ai = 0; ai < 2; ++ai)
#pragma unroll
                        for (int m = 0; m < 4; ++m) { const int row = row0 + ai * HALF + m * 16, pos = row & (S - 1);
                            const f32x4* cp = (const f32x4*)(cs + ((size_t)pos * 16 + f0) * 2); const f32x4 c01 = cp[0], c23 = cp[1];
                            const f32x4 v0 = acc[ai][bj][m][0], v1 = acc[ai][bj][m][1]; const float sc = rs[ai][m];
                            const float a0 = (v0[0] * c01[0] - v0[1] * c01[1]) * sc, b0 = (v0[1] * c01[0] + v0[0] * c01[1]) * sc;
                            const float a1 = (v0[2] * c01[2] - v0[3] * c01[3]) * sc, b1 = (v0[3] * c01[2] + v0[2] * c01[3]) * sc;
                            const float a2 = (v1[0] * c23[0] - v1[1] * c23[1]) * sc, b2 = (v1[1] * c23[0] + v1[0] * c23[1]) * sc;
                            const float a3 = (v1[2] * c23[2] - v1[3] * c23[3]) * sc, b3 = (v1[3] * c23[2] + v1[2] * c23[3]) * sc;
                            bf16_t* hp = base + (size_t)row * 768 + head * 96 + 64 + f0;
                            u32x2e w1, w2; w1.x = cvtpk(a0, a1); w1.y = cvtpk(a2, a3); w2.x = cvtpk(b0, b1); w2.y = cvtpk(b2, b3);
                            *(u32x2e*)hp = w1; *(u32x2e*)(hp + 16) = w2; } }
            }
        } else if (mode == EM_K || mode == EM_V) {
            bf16_t* kbase = (bf16_t*)(ws + WS_K); bf16_t* vbase = (bf16_t*)(ws + WS_VT);
#pragma unroll
            for (int ai = 0; ai < 2; ++ai)
#pragma unroll
                for (int m = 0; m < 4; ++m) { const int row = row0 + ai * HALF + m * 16, pos = row & (S - 1), seq = row >> sshift; const float r = rstd_row(SQKV, row, 1.f / 256.f);
#pragma unroll
                    for (int bj = 0; bj < 2; ++bj) { const int C0 = (pn & 1) * 256 + bj * HALF + cw, head = C0 >> 6, w = C0 & 63;
                        const f32x4 v0 = acc[ai][bj][m][0] * r, v1 = acc[ai][bj][m][1] * r;
                        if (pn < 2) *(u32x4*)(kbase + (size_t)row * 768 + head * 96 + w) = pack8(v0, v1);
                        else { bf16_t* vp = vbase + ((size_t)((seq * 8 + head) * 64 + w)) * S + pos;
                            vp[0] = f2bf(v0[0]); vp[(size_t)S] = f2bf(v0[1]); vp[(size_t)2 * S] = f2bf(v0[2]); vp[(size_t)3 * S] = f2bf(v0[3]);
                            vp[(size_t)4 * S] = f2bf(v1[0]); vp[(size_t)5 * S] = f2bf(v1[1]); vp[(size_t)6 * S] = f2bf(v1[2]); vp[(size_t)7 * S] = f2bf(v1[3]); } } }
        } else if (mode == EM_MRG) {
            const bf16_t* gates = (const bf16_t*)(ws + WS_GATES); bf16_t* mrg = (bf16_t*)(ws + WS_MRG);
#pragma unroll
            for (int ai = 0; ai < 2; ++ai)
#pragma unroll
                for (int m = 0; m < 4; ++m) { const int row = row0 + ai * HALF + m * 16;
#pragma unroll
                    for (int bj = 0; bj < 2; ++bj) { const int C0 = pn * 256 + bj * HALF + cw;
                        const u32x4 g = *(const u32x4*)(gates + (size_t)row * 3072 + 2048 + C0);
                        f32x4 v0 = acc[ai][bj][m][0], v1 = acc[ai][bj][m][1];
                        v0[0] *= bflo(g.x); v0[1] *= bfhi(g.x); v0[2] *= bflo(g.y); v0[3] *= bfhi(g.y); v1[0] *= bflo(g.z); v1[1] *= bfhi(g.z); v1[2] *= bflo(g.w); v1[3] *= bfhi(g.w);
                        *(u32x4*)(mrg + (size_t)row * 1024 + C0) = pack8(v0, v1); } }
        } else if (mode == EM_WO || mode == EM_FF2) {
            const bf16_t* hb = (const bf16_t*)(ws + WS_H); bf16_t* dst = (mode == EM_FF2 && flag) ? (bf16_t*)(ws + WS_MRG) : (bf16_t*)(ws + WS_H);
            sq_t* sq = mode == EM_WO ? SQMID : (flag ? SQX + 4 * TCH : SQX);
#pragma unroll
            for (int ai = 0; ai < 2; ++ai)
#pragma unroll
                for (int m = 0; m < 4; ++m) { const int row = row0 + ai * HALF + m * 16; float ss = 0.f;
#pragma unroll
                    for (int bj = 0; bj < 2; ++bj) { const size_t o = (size_t)row * 1024 + pn * 256 + bj * HALF + cw;
                        const u32x4 xi = *(const u32x4*)(hb + o); f32x4 r0 = acc[ai][bj][m][0], r1 = acc[ai][bj][m][1];
                        r0[0] += bflo(xi.x); r0[1] += bfhi(xi.x); r0[2] += bflo(xi.y); r0[3] += bfhi(xi.y); r1[0] += bflo(xi.z); r1[1] += bfhi(xi.z); r1[2] += bflo(xi.w); r1[3] += bfhi(xi.w);
                        *(u32x4*)(dst + o) = pack8(r0, r1); ss += sumsq8(r0, r1); }
                    row_atomic(sq, row, ss, lane, fq); }
        } else {
            bf16_t* base = (bf16_t*)(ws + WS_FF);
#pragma unroll
            for (int ai = 0; ai < 2; ++ai)
#pragma unroll
                for (int m = 0; m < 4; ++m) { const int row = row0 + ai * HALF + m * 16; bf16_t* rowp = base + (size_t)row * 4096 + pn * 256 + cw; const float r = rstd_row(SQMID, row, 1.f / 1024.f);
#pragma unroll
                    for (int bj = 0; bj < 2; ++bj) { f32x4 v0 = acc[ai][bj][m][0], v1 = acc[ai][bj][m][1];
#pragma unroll
                        for (int e = 0; e < 4; ++e) { const float x0 = fmaxf(v0[e], 0.f) * r, x1 = fmaxf(v1[e], 0.f) * r; v0[e] = x0 * x0; v1[e] = x1 * x1; }
                        *(u32x4*)(rowp + bj * HALF) = pack8(v0, v1); } }
        }
    }
};

template <class Epi, class Sched, bool ALIGN_EPI = false, bool SP2 = false>
__device__ __forceinline__ void gemm_phase(PG8_LAS unsigned char* lds, const Gemm g, const Sched& S, const Epi& E, const int tid) {
    const int wid = __builtin_amdgcn_readfirstlane(tid >> 6), lane = tid & 63, wr = wid >> 2, wc = wid & 3, fr = lane & 15, fq = lane >> 4;
    const int K = g.K, nt = K / BK;
    unsigned voffA[2], voffB[2];
#pragma unroll
    for (int i = 0; i < 2; ++i) { int R, C; stage_rc(tid * 16 + i * 8192, R, C); const int Rb = Epi::PERM ? ((R & ~31) + perm32(R & 31)) : R;
        voffA[i] = (unsigned)(R * g.lda + C) * 2u; voffB[i] = (unsigned)(Rb * K + C) * 2u; }
    const size_t kstep = (size_t)(BK * 2);
    const size_t hstepA = (size_t)HALF * g.lda * 2, hstepB = (size_t)HALF * K * 2;
    const size_t tstepA = 2 * hstepA, tstepB = 2 * hstepB;
    const unsigned ldsw = (unsigned)wid * 1024u;
    const int aoff = lds_byte(wr * 64 + fr, fq * 8), boff = lds_byte(wc * 32 + fr, fq * 8);
#define PG8_SA(b, h) (((b) * 2 + (h)) * HTB)
#define PG8_SB(b, h) ((4 + (b) * 2 + (h)) * HTB)
#define PG8_STAGE(bufoff, gbase, voff) do { _Pragma("unroll") for (int _i = 0; _i < 2; ++_i) \
        __builtin_amdgcn_global_load_lds((const unsigned*)((const char*)(gbase) + (voff)[_i]), (PG8_LAS unsigned*)(lds + (bufoff) + ldsw + _i * 8192), 16, 0, 0); } while (0)
#define PG8_LDA(dst, b, h) do { _Pragma("unroll") for (int m = 0; m < 4; ++m) _Pragma("unroll") for (int k = 0; k < 2; ++k) dst[m][k] = *(const PG8_LAS bf16x8*)(lds + PG8_SA(b, h) + aoff + m * 2048 + k * 1024); } while (0)
#define PG8_LDB(dst, b, h) do { _Pragma("unroll") for (int n = 0; n < 2; ++n) _Pragma("unroll") for (int k = 0; k < 2; ++k) dst[n][k] = *(const PG8_LAS bf16x8*)(lds + PG8_SB(b, h) + boff + n * 2048 + k * 1024); } while (0)
#define PG8_MMA(ai, bj, At, Bt) do { __builtin_amdgcn_s_setprio(1); _Pragma("unroll") for (int m = 0; m < 4; ++m) _Pragma("unroll") for (int n = 0; n < 2; ++n) _Pragma("unroll") for (int k = 0; k < 2; ++k) \
        acc[ai][bj][m][n] = __builtin_amdgcn_mfma_f32_16x16x32_bf16(Bt[n][k], At[m][k], acc[ai][bj][m][n], 0, 0, 0); __builtin_amdgcn_s_setprio(0); } while (0)
#define PG8_WAIT_V(n) asm volatile("s_waitcnt vmcnt(" #n ")" ::: "memory")
#define PG8_WAIT_L(n) asm volatile("s_waitcnt lgkmcnt(" #n ")" ::: "memory")
#define PG8_BAR __builtin_amdgcn_s_barrier()
#define PG8_SCHED __builtin_amdgcn_sched_barrier(0)
    Unit cur, nxt; int ui = 0;
    if (!S.next(0, cur)) return;
    f32x4 acc[2][2][4][2];
#pragma unroll
    for (int a = 0; a < 2; ++a)
#pragma unroll
        for (int b = 0; b < 2; ++b)
#pragma unroll
            for (int m = 0; m < 4; ++m)
#pragma unroll
                for (int n = 0; n < 2; ++n) acc[a][b][m][n] = (f32x4){0.f, 0.f, 0.f, 0.f};
    bf16x8 At[4][2], B0[2][2], B1[2][2];
    const char* cA = (const char*)g.A + (size_t)cur.pm * tstepA; const char* cB = (const char*)g.Bt + (size_t)cur.pn * tstepB;
    S.a_ready(cur);
    if constexpr (SP2) {
        PG8_STAGE(PG8_SB(0, 0), cB, voffB); PG8_STAGE(PG8_SB(0, 1), cB + hstepB, voffB); PG8_STAGE(PG8_SA(0, 0), cA, voffA); PG8_STAGE(PG8_SA(0, 1), cA + hstepA, voffA);
        if (wr == 1) PG8_BAR;
        PG8_WAIT_V(2); PG8_BAR;
        PG8_STAGE(PG8_SB(1, 0), cB + kstep, voffB); PG8_STAGE(PG8_SA(1, 0), cA + kstep, voffA); PG8_STAGE(PG8_SB(1, 1), cB + hstepB + kstep, voffB);
        PG8_WAIT_V(6); PG8_BAR;
    } else {
        PG8_STAGE(PG8_SB(0, 0), cB, voffB); PG8_STAGE(PG8_SA(0, 0), cA, voffA); PG8_STAGE(PG8_SB(0, 1), cB + hstepB, voffB); PG8_STAGE(PG8_SA(0, 1), cA + hstepA, voffA);
        if (wr == 1) PG8_BAR;
        PG8_WAIT_V(4); PG8_BAR;
        PG8_STAGE(PG8_SB(1, 0), cB + kstep, voffB); PG8_STAGE(PG8_SA(1, 0), cA + kstep, voffA); PG8_STAGE(PG8_SB(1, 1), cB + hstepB + kstep, voffB);
        PG8_WAIT_V(6); PG8_BAR;
    }
    for (;;) {
        const bool has_next = S.next(ui + 1, nxt);
        const char* nA = has_next ? (const char*)g.A + (size_t)nxt.pm * tstepA : cA; const char* nB = has_next ? (const char*)g.Bt + (size_t)nxt.pn * tstepB : cB;
        for (int t = 0; t < nt; t += 2) {
            if constexpr (Epi::KHOOK) { if (t == 8 || t == 16) E.khook(acc, cur, t, wr, wc, fr, fq); }
            const bool last = (t == nt - 2);
            const char* a1 = cA + (size_t)(t + 1) * kstep;
            const char* a2 = last ? nA : cA + (size_t)(t + 2) * kstep; const char* b2 = last ? nB : cB + (size_t)(t + 2) * kstep;
            const char* a3 = a2 + kstep; const char* b3 = b2 + kstep;
            if (last && has_next) S.a_ready(nxt);
            if constexpr (SP2) {
            PG8_LDB(B0, 0, 0); PG8_LDB(B1, 0, 1); PG8_SCHED; PG8_LDA(At, 0, 0); PG8_STAGE(PG8_SA(1, 1), a1 + hstepA, voffA);
            PG8_WAIT_V(8); PG8_WAIT_L(0); PG8_BAR; PG8_MMA(0, 0, At, B0); PG8_MMA(0, 1, At, B1); PG8_BAR; PG8_SCHED;
            PG8_LDA(At, 0, 1); PG8_STAGE(PG8_SB(0, 0), b2, voffB); PG8_STAGE(PG8_SB(0, 1), b2 + hstepB, voffB); PG8_STAGE(PG8_SA(0, 0), a2, voffA);
            PG8_WAIT_V(8); PG8_WAIT_L(0); PG8_BAR; PG8_MMA(1, 0, At, B0); PG8_MMA(1, 1, At, B1); PG8_BAR; PG8_SCHED;
            PG8_LDB(B0, 1, 0); PG8_LDB(B1, 1, 1); PG8_SCHED; PG8_LDA(At, 1, 0); PG8_STAGE(PG8_SA(0, 1), a2 + hstepA, voffA);
            PG8_WAIT_V(8); PG8_WAIT_L(0); PG8_BAR; PG8_MMA(0, 0, At, B0); PG8_MMA(0, 1, At, B1); PG8_BAR; PG8_SCHED;
            PG8_LDA(At, 1, 1); PG8_STAGE(PG8_SB(1, 0), b3, voffB); PG8_STAGE(PG8_SB(1, 1), b3 + hstepB, voffB); PG8_STAGE(PG8_SA(1, 0), a3, voffA);
            PG8_WAIT_V(8); PG8_WAIT_L(0); PG8_BAR; PG8_MMA(1, 0, At, B0); PG8_MMA(1, 1, At, B1); PG8_BAR; PG8_SCHED;
            } else {
            PG8_LDB(B0, 0, 0); PG8_SCHED; PG8_LDA(At, 0, 0); PG8_STAGE(PG8_SA(1, 1), a1 + hstepA, voffA);
            PG8_WAIT_L(8); PG8_BAR; PG8_WAIT_L(0); PG8_MMA(0, 0, At, B0); PG8_BAR; PG8_SCHED;
            PG8_LDB(B1, 0, 1); PG8_STAGE(PG8_SB(0, 0), b2, voffB);
            PG8_BAR; PG8_WAIT_L(0); PG8_MMA(0, 1, At, B1); PG8_BAR;
            PG8_LDA(At, 0, 1); PG8_STAGE(PG8_SA(0, 0), a2, voffA);
            PG8_BAR; PG8_WAIT_L(0); PG8_MMA(1, 0, At, B0); PG8_BAR; PG8_SCHED;
            PG8_STAGE(PG8_SB(0, 1), b2 + hstepB, voffB);
            PG8_WAIT_V(6); PG8_BAR; PG8_MMA(1, 1, At, B1); PG8_BAR;
            PG8_LDB(B0, 1, 0); PG8_SCHED; PG8_LDA(At, 1, 0); PG8_STAGE(PG8_SA(0, 1), a2 + hstepA, voffA);
            PG8_WAIT_L(8); PG8_BAR; PG8_WAIT_L(0); PG8_MMA(0, 0, At, B0); PG8_BAR; PG8_SCHED;
            PG8_LDB(B1, 1, 1); PG8_STAGE(PG8_SB(1, 0), b3, voffB);
            PG8_BAR; PG8_WAIT_L(0); PG8_MMA(0, 1, At, B1); PG8_BAR;
            PG8_LDA(At, 1, 1); PG8_STAGE(PG8_SA(1, 0), a3, voffA);
            PG8_BAR; PG8_WAIT_L(0); PG8_MMA(1, 0, At, B0); PG8_BAR; PG8_SCHED;
            PG8_STAGE(PG8_SB(1, 1), b3 + hstepB, voffB);
            PG8_WAIT_V(6); PG8_BAR; PG8_MMA(1, 1, At, B1); PG8_BAR;
            }
        }
        if constexpr (ALIGN_EPI) { if (wr == 0) PG8_BAR; }
        if constexpr (!Epi::AFTER_DRAIN) { E(acc, cur, wr, wc, fr, fq); if constexpr (Epi::DUP) { if (Epi::dup_tile(cur.pn)) { Epi E2 = E; if (PROBE == 36) E2.flag |= 4; E2(acc, cur, wr, wc, fr, fq); } } S.done(cur); }
        if (!has_next) break;
#pragma unroll
        for (int a = 0; a < 2; ++a)
#pragma unroll
            for (int b = 0; b < 2; ++b)
#pragma unroll
                for (int m = 0; m < 4; ++m)
#pragma unroll
                    for (int n = 0; n < 2; ++n) acc[a][b][m][n] = (f32x4){0.f, 0.f, 0.f, 0.f};
        cur = nxt; cA = nA; cB = nB; ++ui;
        if constexpr (ALIGN_EPI) { if (wr == 1) PG8_BAR; }
    }
    PG8_WAIT_V(0);
    if constexpr (!ALIGN_EPI) { if (wr == 0) PG8_BAR; }
    PG8_BAR;
    if constexpr (Epi::AFTER_DRAIN) { E.fused(acc, cur, wr, wc, fr, fq, lds, wid, lane); S.done(cur); }
#undef PG8_SA
#undef PG8_SB
#undef PG8_STAGE
#undef PG8_LDA
#undef PG8_LDB
#undef PG8_MMA
#undef PG8_WAIT_V
#undef PG8_WAIT_L
#undef PG8_BAR
#undef PG8_SCHED
}
}

using pg8::bf16_t; using pg8::bf16x8; using pg8::f32x4; using pg8::u32x4;
#define MFMA32(a, b, c) __builtin_amdgcn_mfma_f32_32x32x16_bf16((a), (b), (c), 0, 0, 0)

DI int win_src(int n) {
    if (n < 512) return n;
    if (n < 1280) { const int j = n - 512; if (j < 640) return 512 + j; if (j >= 672) return -1; const int p = j - 640; return 1152 + (p >> 1) + 16 * (p & 1); }
    if (n < 4352) { int q = n - 1280, base = 1184; if (q >= 1536) { q -= 1536; base = 2720; } const int hh = q >> 7, p = q & 127; return base + hh * 128 + (p >> 1) + 64 * (p & 1); }
    if (n < 5888) return 4256 + (n - 4352);
    return 5792 + (n - 5888);
}
DI int wuq_src(int n) { const int head = n / 96, w = n - head * 96; if (w < 64) return n; const int p = w - 64; return head * 96 + 64 + (p >> 1) + 16 * (p & 1); }

template <int MAP> DI void conv_items(const float* __restrict__ W, int K, int Nsrc, bf16_t* __restrict__ dst, int Nphys, int gtid, int NGT, int ldd = 0, int coff = 0, const float* __restrict__ gain = nullptr) {
    if (ldd == 0) ldd = K;
    const int nitems = Nphys * (K >> 3);
#pragma unroll 4
    for (int it = gtid; it < nitems; it += NGT) {
        const int n = it % Nphys, kg = it / Nphys; const int src = MAP == 1 ? win_src(n) : (MAP == 2 ? wuq_src(n) : n);
        u32x4 o = {0u, 0u, 0u, 0u};
        if (src >= 0) { const float* p = W + (size_t)(kg * 8) * Nsrc + src;
            float v0 = p[0], v1 = p[(size_t)Nsrc], v2 = p[(size_t)2 * Nsrc], v3 = p[(size_t)3 * Nsrc], v4 = p[(size_t)4 * Nsrc], v5 = p[(size_t)5 * Nsrc], v6 = p[(size_t)6 * Nsrc], v7 = p[(size_t)7 * Nsrc];
            if (gain) { const f32x4 g0 = *(const f32x4*)(gain + kg * 8), g1 = *(const f32x4*)(gain + kg * 8 + 4); v0 *= g0[0]; v1 *= g0[1]; v2 *= g0[2]; v3 *= g0[3]; v4 *= g1[0]; v5 *= g1[1]; v6 *= g1[2]; v7 *= g1[3]; }
            o.x = cvtpk(v0, v1); o.y = cvtpk(v2, v3); o.z = cvtpk(v4, v5); o.w = cvtpk(v6, v7); }
        *(u32x4*)(dst + (size_t)n * ldd + coff + kg * 8) = o;
    }
}
DI void conv_weff(const float* poolw, const float* scale, const float* wa, bf16_t* dst, int gtid, int NGT) {
    for (int it = gtid; it < 1024 * 64; it += NGT) {
        const int n = it & 1023, kg = it >> 10, k0 = kg * 8, g = k0 >> 7, c0 = k0 & 127;
        float a0 = 0.f, a1 = 0.f, a2 = 0.f, a3 = 0.f, a4 = 0.f, a5 = 0.f, a6 = 0.f, a7 = 0.f;
        const float* pw = poolw + ((size_t)g * 128 + c0) * 128;
        for (int d = 0; d < 128; ++d) { const float wv = scale[g * 128 + d] * wa[(size_t)(g * 128 + d) * 1024 + n];
            a0 += pw[d] * wv; a1 += pw[128 + d] * wv; a2 += pw[256 + d] * wv; a3 += pw[384 + d] * wv; a4 += pw[512 + d] * wv; a5 += pw[640 + d] * wv; a6 += pw[768 + d] * wv; a7 += pw[896 + d] * wv; }
        u32x4 o; o.x = cvtpk(a0, a1); o.y = cvtpk(a2, a3); o.z = cvtpk(a4, a5); o.w = cvtpk(a6, a7);
        *(u32x4*)(dst + (size_t)n * 1536 + k0) = o;
    }
}
DI void rope_table(float* cs, int half, double cbase, int gtid, int NGT) {
    const int n = 8192 * half;
    for (int it = gtid; it < n; it += NGT) {
        const int pos = it / half, f = it - pos * half;
        double inv = 1.0; for (int i = 0; i < f; ++i) inv *= cbase;
        const double rev = (double)pos * inv * 0.15915494309189535;
        const float fr = (float)(rev - __builtin_rint(rev));
        cs[2 * (size_t)it] = __builtin_amdgcn_cosf(fr); cs[2 * (size_t)it + 1] = __builtin_amdgcn_sinf(fr);
    }
}

DI void rms_rows_bf16(const float* x, const float* g, bf16_t* out, int nrows, int gw, int NGW, int lane) {
    for (int row = gw; row < nrows; row += NGW) {
        const f32x4* xr = (const f32x4*)(x + (size_t)row * 1024) + lane; f32x4 v[4]; float s = 0.f;
#pragma unroll
        for (int j = 0; j < 4; ++j) { v[j] = xr[64 * j]; s += (v[j][0] * v[j][0] + v[j][1] * v[j][1]) + (v[j][2] * v[j][2] + v[j][3] * v[j][3]); }
        const float rstd = 1.f / sqrtf(wave_sum(s, lane) * (1.f / 1024.f) + RMS_EPS);
        u32x2* o8 = (u32x2*)(out + (size_t)row * 1024) + lane;
#pragma unroll
        for (int j = 0; j < 4; ++j) { const f32x4 gg = ((const f32x4*)g)[lane + 64 * j]; u32x2 w; w.x = cvtpk(v[j][0] * rstd * gg[0], v[j][1] * rstd * gg[1]); w.y = cvtpk(v[j][2] * rstd * gg[2], v[j][3] * rstd * gg[3]); o8[64 * j] = w; }
    }
}
DI void final_rows(const bf16_t* x, const sq_t* sq, const float* g, float* out, int nrows, int gw, int NGW, int lane) {
    for (int row0 = gw; row0 < nrows; row0 += 4 * NGW) {
        u32x2 v[4][4]; float rstd[4];
#pragma unroll
        for (int u = 0; u < 4; ++u) { const int row = row0 + u * NGW; if (row < nrows) { const u32x2* xr = (const u32x2*)(x + (size_t)row * 1024) + lane;
#pragma unroll
                for (int j = 0; j < 4; ++j) v[u][j] = xr[64 * j];
                rstd[u] = 1.f / sqrtf((float)sq[row] * (1.f / 1024.f / 16777216.f) + RMS_EPS); } }
#pragma unroll
        for (int u = 0; u < 4; ++u) { const int row = row0 + u * NGW; if (row < nrows) { f32x4* o = (f32x4*)(out + (size_t)row * 1024) + lane;
#pragma unroll
                for (int j = 0; j < 4; ++j) { const f32x4 gg = ((const f32x4*)g)[lane + 64 * j]; const float r = rstd[u];
                    f32x4 y; y[0] = bflo(v[u][j].x) * r * gg[0]; y[1] = bfhi(v[u][j].x) * r * gg[1]; y[2] = bflo(v[u][j].y) * r * gg[2]; y[3] = bfhi(v[u][j].y) * r * gg[3]; o[64 * j] = y; } } }
    }
}
DI void unpack8(const u32x4& r, float (&v)[8]) { v[0] = bflo(r.x); v[1] = bfhi(r.x); v[2] = bflo(r.y); v[3] = bfhi(r.y); v[4] = bflo(r.z); v[5] = bfhi(r.z); v[6] = bflo(r.w); v[7] = bfhi(r.w); }
DI void p0_rows(const float* x, bf16_t* out, sq_t* sq, int nrows, int gw, int NGW, int lane) {
    for (int row0 = gw; row0 < nrows; row0 += 4 * NGW) {
        f32x4 v[4][4];
#pragma unroll
        for (int u = 0; u < 4; ++u) { const int row = row0 + u * NGW; if (row < nrows) { const f32x4* xr = (const f32x4*)(x + (size_t)row * 1024) + lane;
#pragma unroll
                for (int j = 0; j < 4; ++j) v[u][j] = xr[64 * j]; } }
#pragma unroll
        for (int u = 0; u < 4; ++u) { const int row = row0 + u * NGW; if (row < nrows) { float s = 0.f;
#pragma unroll
                for (int j = 0; j < 4; ++j) s += (v[u][j][0] * v[u][j][0] + v[u][j][1] * v[u][j][1]) + (v[u][j][2] * v[u][j][2] + v[u][j][3] * v[u][j][3]);
                s = wave_sum(s, lane);
                u32x2* o8 = (u32x2*)(out + (size_t)row * 1024) + lane;
#pragma unroll
                for (int j = 0; j < 4; ++j) { u32x2 w; w.x = cvtpk(v[u][j][0], v[u][j][1]); w.y = cvtpk(v[u][j][2], v[u][j][3]); o8[64 * j] = w; }
                if (lane == 0) sq[row] = (sq_t)(s * 16777216.f); } }
    }
}
DI void pool_rows(unsigned char* ws, int S, int gw, int NGW, int lane) {
    const bf16_t* UP = (const bf16_t*)(ws + WS_UP); bf16_t* MIX = (bf16_t*)(ws + WS_BR);
    for (int t = gw; t < TCH; t += NGW) {
        const int pos = t & (S - 1);
        const int g = lane >> 4, hw = 1 << g; const int lo = max(pos - hw, 0), hi = min(pos + hw, S); const size_t tb = (size_t)(t - pos);
        float a[8] = {0.f, 0.f, 0.f, 0.f, 0.f, 0.f, 0.f, 0.f};
        for (int j = lo; j < hi; ++j) { float v[8]; const u32x4 raw = *(const u32x4*)(UP + (tb + j) * 512 + lane * 8); unpack8(raw, v);
#pragma unroll
            for (int i = 0; i < 8; ++i) a[i] += v[i]; }
        const float rc = 1.f / (float)(hi - lo); float sv[8]; const u32x4 raw = *(const u32x4*)(UP + (size_t)t * 512 + lane * 8); unpack8(raw, sv);
        u32x4 o; o.x = cvtpk(a[0] * rc - sv[0], a[1] * rc - sv[1]); o.y = cvtpk(a[2] * rc - sv[2], a[3] * rc - sv[3]); o.z = cvtpk(a[4] * rc - sv[4], a[5] * rc - sv[5]); o.w = cvtpk(a[6] * rc - sv[6], a[7] * rc - sv[7]);
        __builtin_nontemporal_store(o, (u32x4*)(MIX + (size_t)t * 1536 + lane * 8));
    }
}
DI void zero_sq(sq_t* p, int n, int gtid, int NGT) {
#pragma clang loop unroll(disable) vectorize(disable)
    for (int i = gtid; i < n; i += NGT) p[i] = 0ull;
}
DI void t2_rows(unsigned char* ws, int gw, int NGW, int lane) {
    const bf16_t* OG = (const bf16_t*)(ws + WS_OG); const float* LSE = (const float*)(ws + WS_LSE); bf16_t* CB = (bf16_t*)(ws + WS_BR) + 1024;
    const int head = lane >> 4;
    for (int t0 = gw; t0 < TCH; t0 += 2 * NGW) {
        u32x4 raw[2][3]; float ls[2][3];
#pragma unroll
        for (int u = 0; u < 2; ++u) { const int t = t0 + u * NGW; if (t < TCH) {
#pragma unroll
                for (int gq = 0; gq < 3; ++gq) { ls[u][gq] = LSE[((size_t)gq * TCH + t) * 4 + head]; raw[u][gq] = *(const u32x4*)(OG + ((size_t)gq * TCH + t) * 512 + lane * 8); } } }
#pragma unroll
        for (int u = 0; u < 2; ++u) { const int t = t0 + u * NGW; if (t < TCH) {
                const float M = fmaxf(ls[u][0], fmaxf(ls[u][1], ls[u][2])); float w0 = fexp2(ls[u][0] - M), w1 = fexp2(ls[u][1] - M), w2 = fexp2(ls[u][2] - M); const float rs = 1.f / (w0 + w1 + w2); w0 *= rs; w1 *= rs; w2 *= rs;
                float v0[8], v1[8], v2[8]; unpack8(raw[u][0], v0); unpack8(raw[u][1], v1); unpack8(raw[u][2], v2);
                float r[8];
#pragma unroll
                for (int i = 0; i < 8; ++i) r[i] = w0 * v0[i] + w1 * v1[i] + w2 * v2[i];
                u32x4 o; o.x = cvtpk(r[0], r[1]); o.y = cvtpk(r[2], r[3]); o.z = cvtpk(r[4], r[5]); o.w = cvtpk(r[6], r[7]);
                __builtin_nontemporal_store(o, (u32x4*)(CB + (size_t)t * 1536 + lane * 8)); } }
    }
}

DI float vmax16(const f32x16& s) { return fmaxf(fmaxf(fmaxf(fmaxf(s[0], s[1]), fmaxf(s[2], s[3])), fmaxf(fmaxf(s[4], s[5]), fmaxf(s[6], s[7]))), fmaxf(fmaxf(fmaxf(s[8], s[9]), fmaxf(s[10], s[11])), fmaxf(fmaxf(s[12], s[13]), fmaxf(s[14], s[15])))); }
DI float exp_sum16(f32x16& s, float m) { float t = 0.f;
#pragma unroll
    for (int i = 0; i < 16; ++i) { s[i] = fexp2(s[i] - m); t += s[i]; }
    return t; }
DI bf16x8 packp(const f32x16& p, const int s2) { u32x4 w; w.x = cvtpk(p[8 * s2], p[8 * s2 + 1]); w.y = cvtpk(p[8 * s2 + 2], p[8 * s2 + 3]); w.z = cvtpk(p[8 * s2 + 4], p[8 * s2 + 5]); w.w = cvtpk(p[8 * s2 + 6], p[8 * s2 + 7]); return __builtin_bit_cast(bf16x8, w); }
DI bf16x8 cat44(const s16x4& lo, const s16x4& hi) { return __builtin_shufflevector(lo, hi, 0, 1, 2, 3, 4, 5, 6, 7); }
DI f32x16 zero16() { f32x16 z;
#pragma unroll
    for (int i = 0; i < 16; ++i) z[i] = 0.f;
    return z; }

constexpr int MLA_KP = 208, MLA_VP = 136, MLA_KBYTES = 64 * MLA_KP, MLA_VBYTES = 64 * MLA_VP, MLA_BUF = MLA_KBYTES + MLA_VBYTES, MLA_SLOT = 2 * MLA_BUF;
template <bool FAST> DI bool mla_unit(unsigned char* lds, unsigned char* ws, int seq, int head, int qb, int S, int tid, int wave, int lane) {
    const bf16_t* Q = (const bf16_t*)(ws + WS_Q); const bf16_t* K = (const bf16_t*)(ws + WS_K); const bf16_t* VT = (const bf16_t*)(ws + WS_VT); bf16_t* BB = (bf16_t*)(ws + WS_BR) + 512;
    const int r = lane & 31, h = lane >> 5;
    const size_t tokq = (size_t)seq * S + qb * 256 + wave * 32 + r;
    const bf16_t* qp = Q + tokq * 768 + head * 96 + 8 * h;
    bf16x8 qf[6];
#pragma unroll
    for (int s = 0; s < 6; ++s) qf[s] = *(const bf16x8*)(qp + 16 * s);
    f32x16 o0 = zero16(), o1 = zero16(); float mrun = -1e30f, lrun = 0.f;
    const int kr0 = tid / 12, kc0 = tid - kr0 * 12; const int t2_ = tid < 256 ? tid + 512 : tid; const int kr1 = t2_ / 12, kc1 = t2_ - kr1 * 12;
    const int vr = tid >> 3, vc = tid & 7;
    const bf16_t* kbase = K + ((size_t)seq * S) * 768 + head * 96;
    const bf16_t* vbase = VT + ((size_t)(seq * 8 + head) * 64) * S;
    u32x4 kA0, kB0, vv0, kA1, kB1, vv1;
#define MLA_LOAD(it) do { const int key0_ = (it) * 128; const bf16_t* k0_ = kbase + (size_t)(key0_ + kr0) * 768 + kc0 * 8; const bf16_t* k1_ = kbase + (size_t)(key0_ + kr1) * 768 + kc1 * 8; const bf16_t* v_ = vbase + (size_t)vr * S + key0_ + vc * 8; \
        kA0 = *(const u32x4*)k0_; kB0 = *(const u32x4*)k1_; vv0 = *(const u32x4*)v_; kA1 = *(const u32x4*)(k0_ + 64 * 768); kB1 = *(const u32x4*)(k1_ + 64 * 768); vv1 = *(const u32x4*)(v_ + 64); } while (0)
#define MLA_ST1(b_, kA, kB, vv) do { *(u32x4*)((b_) + kr0 * MLA_KP + kc0 * 16) = kA; *(u32x4*)((b_) + kr1 * MLA_KP + kc1 * 16) = kB; \
        unsigned char* v_ = (b_) + MLA_KBYTES + vr * MLA_VP + vc * 16; u32x2 lo_, hi_; lo_.x = vv.x; lo_.y = vv.y; hi_.x = vv.z; hi_.y = vv.w; *(u32x2*)v_ = lo_; *(u32x2*)(v_ + 8) = hi_; } while (0)
#define MLA_STORE(slot) do { unsigned char* sb_ = lds + (slot) * MLA_SLOT; MLA_ST1(sb_, kA0, kB0, vv0); MLA_ST1(sb_ + MLA_BUF, kA1, kB1, vv1); } while (0)
#define MLA_KL(ka, u) do { const unsigned char* kb_ = sl + ((u) >> 1) * MLA_BUF + (32 * ((u) & 1) + r) * MLA_KP + 16 * h; _Pragma("unroll") for (int s = 0; s < 6; ++s) ka[s] = *(const bf16x8*)(kb_ + 32 * s); } while (0)
#define MLA_QK(sx, ka) do { sx = zero16(); _Pragma("unroll") for (int s = 0; s < 6; ++s) sx = MFMA32(ka[s], qf[s], sx); } while (0)
#define MLA_VL(va, vc2, u) do { const unsigned char* vb_ = sl + ((u) >> 1) * MLA_BUF + MLA_KBYTES + r * MLA_VP + 8 * h + 64 * ((u) & 1); \
        _Pragma("unroll") for (int j = 0; j < 2; ++j) { va[j] = cat44(*(const s16x4*)(vb_ + 32 * j), *(const s16x4*)(vb_ + 32 * j + 16)); vc2[j] = cat44(*(const s16x4*)(vb_ + 32 * MLA_VP + 32 * j), *(const s16x4*)(vb_ + 32 * MLA_VP + 32 * j + 16)); } } while (0)
#define MLA_SMF(sx, pa, pb) do { float ps_ = 0.f; _Pragma("unroll") for (int i = 0; i < 16; ++i) { sx[i] = fexp2(sx[i]); ps_ += sx[i]; } lrun += ps_; pa = packp(sx, 0); pb = packp(sx, 1); } while (0)
#define MLA_PV(va, vc2, pa, pb) do { o0 = MFMA32(va[0], pa, o0); o1 = MFMA32(vc2[0], pa, o1); o0 = MFMA32(va[1], pb, o0); o1 = MFMA32(vc2[1], pb, o1); } while (0)
#define SB() __builtin_amdgcn_sched_barrier(0)
    const int nit = S >> 7;
    MLA_LOAD(0); MLA_STORE(0); __syncthreads();
    for (int it = 0; it < nit; ++it) {
        const unsigned char* sl = lds + (it & 1) * MLA_SLOT;
        MLA_LOAD(min(it + 1, nit - 1)); SB();
        if constexpr (FAST) {
            bf16x8 kaA[6], kaB[6], vaA[2], vcA[2], vaB[2], vcB[2], paA, pbA, paB, pbB; f32x16 sA, sB;
            MLA_KL(kaA, 0); MLA_KL(kaB, 1);
            MLA_QK(sA, kaA);
            MLA_QK(sB, kaB); MLA_SMF(sA, paA, pbA); MLA_VL(vaA, vcA, 0); MLA_KL(kaA, 2);
            MLA_PV(vaA, vcA, paA, pbA); MLA_QK(sA, kaA); MLA_SMF(sB, paB, pbB); MLA_VL(vaB, vcB, 1); MLA_KL(kaB, 3);
            MLA_PV(vaB, vcB, paB, pbB); MLA_QK(sB, kaB); MLA_SMF(sA, paA, pbA); MLA_VL(vaA, vcA, 2);
            MLA_PV(vaA, vcA, paA, pbA); MLA_SMF(sB, paB, pbB); MLA_VL(vaB, vcB, 3);
            MLA_PV(vaB, vcB, paB, pbB);
        } else {
#pragma unroll
            for (int t = 0; t < 2; ++t) {
                bf16x8 kaA[6], kaB[6], vaA[2], vcA[2], vaB[2], vcB[2]; f32x16 s0, s1;
                MLA_KL(kaA, 2 * t); MLA_KL(kaB, 2 * t + 1); MLA_QK(s0, kaA); MLA_QK(s1, kaB); MLA_VL(vaA, vcA, 2 * t); MLA_VL(vaB, vcB, 2 * t + 1);
                float mx_ = fmaxf(vmax16(s0), vmax16(s1)); mx_ = fmaxf(mx_, shx(mx_, lane, 32));
                const float mnew_ = fmaxf(mrun, mx_), alpha_ = fexp2(mrun - mnew_); mrun = mnew_;
                const float ps_ = exp_sum16(s0, mnew_) + exp_sum16(s1, mnew_); lrun = lrun * alpha_ + ps_; o0 *= alpha_; o1 *= alpha_;
                const bf16x8 p0_ = packp(s0, 0), p1_ = packp(s0, 1), p2_ = packp(s1, 0), p3_ = packp(s1, 1);
                MLA_PV(vaA, vcA, p0_, p1_); MLA_PV(vaB, vcB, p2_, p3_);
            }
        }
        SB(); MLA_STORE((it + 1) & 1); SB();
        __syncthreads();
    }
#undef MLA_LOAD
#undef MLA_ST1
#undef MLA_STORE
#undef MLA_KL
#undef MLA_QK
#undef MLA_VL
#undef MLA_SMF
#undef MLA_PV
#undef SB
    const float l = lrun + shx(lrun, lane, 32), inv = 1.f / l;
    const bool bad = !(l > 1e-30f && l < 1e30f) || (PROBE == 20 && FAST);
    bf16_t* op = BB + tokq * 1536 + head * 64 + 4 * h;
#pragma unroll
    for (int g4 = 0; g4 < 4; ++g4) { u32x2 w; w.x = cvtpk(o0[4 * g4] * inv, o0[4 * g4 + 1] * inv); w.y = cvtpk(o0[4 * g4 + 2] * inv, o0[4 * g4 + 3] * inv); *(u32x2*)(op + 8 * g4) = w;
        u32x2 w2; w2.x = cvtpk(o1[4 * g4] * inv, o1[4 * g4 + 1] * inv); w2.y = cvtpk(o1[4 * g4 + 2] * inv, o1[4 * g4 + 3] * inv); *(u32x2*)(op + 32 + 8 * g4) = w2; }
    return bad;
}

DI void dil_wave(unsigned char* ws, int wt, int S, int sshift, int lane) {
    const bf16_t* QD = (const bf16_t*)(ws + WS_QD); const bf16_t* KD = (const bf16_t*)(ws + WS_KD); const bf16_t* VDT = (const bf16_t*)(ws + WS_VDT); bf16_t* OG = (bf16_t*)(ws + WS_OG); float* LSE = (float*)(ws + WS_LSE);
    const int r = lane & 31, h = lane >> 5;
    const int tps = S >> 5;
    const int wtile = wt % tps, sh = wt / tps, hh = sh % 12, seq = sh / 12;
    const int g = hh >> 2, ds = 2 * g, L = S >> ds, tpr = L >> 5;
    const int res = wtile / tpr, mq0 = (wtile - res * tpr) * 32;
    const size_t tokq = (size_t)seq * S + ((size_t)(mq0 + r) << ds) + res;
    const bf16_t* qp = QD + tokq * 1536 + hh * 128 + 8 * h;
    bf16x8 qf[8];
#pragma unroll
    for (int s = 0; s < 8; ++s) qf[s] = *(const bf16x8*)(qp + 16 * s);
    f32x16 o0 = zero16(), o1 = zero16(), o2 = zero16(), o3 = zero16(); float mrun = -1e30f, lrun = 0.f;
    const bf16_t* vrow = VDT + ((size_t)((seq * 12 + hh) * 128 + r)) * S + (size_t)res * L + 4 * h;
#pragma unroll
    for (int j = 0; j < 5; ++j) {
        const int mk0 = mq0 - 64 + 32 * j;
        if (mk0 < 0 || mk0 >= L) continue;
        const bf16_t* kp = KD + ((size_t)seq * S + ((size_t)(mk0 + r) << ds) + res) * 1536 + hh * 128 + 8 * h;
        f32x16 sc = zero16();
#pragma unroll
        for (int s = 0; s < 8; ++s) { const bf16x8 kf = *(const bf16x8*)(kp + 16 * s); sc = MFMA32(kf, qf[s], sc); }
        if (j == 0 || j == 4) {
#pragma unroll
            for (int i = 0; i < 16; ++i) { const int kr = (i & 3) + 8 * (i >> 2) + 4 * h; const bool ok = (j == 0) ? (kr >= r) : (kr <= r); sc[i] = ok ? sc[i] : -1e30f; }
        }
        float mx = vmax16(sc); mx = fmaxf(mx, shx(mx, lane, 32));
        const float mnew = fmaxf(mrun, mx), alpha = fexp2(mrun - mnew); mrun = mnew;
        const float ps = exp_sum16(sc, mnew);
        lrun = lrun * alpha + ps; o0 *= alpha; o1 *= alpha; o2 *= alpha; o3 *= alpha;
#pragma unroll
        for (int s2 = 0; s2 < 2; ++s2) { const bf16x8 pf = packp(sc, s2); const bf16_t* vp = vrow + mk0 + 16 * s2;
            const bf16x8 v0 = cat44(*(const s16x4*)vp, *(const s16x4*)(vp + 8)); const bf16x8 v1 = cat44(*(const s16x4*)(vp + (size_t)32 * S), *(const s16x4*)(vp + (size_t)32 * S + 8));
            const bf16x8 v2 = cat44(*(const s16x4*)(vp + (size_t)64 * S), *(const s16x4*)(vp + (size_t)64 * S + 8)); const bf16x8 v3 = cat44(*(const s16x4*)(vp + (size_t)96 * S), *(const s16x4*)(vp + (size_t)96 * S + 8));
            o0 = MFMA32(v0, pf, o0); o1 = MFMA32(v1, pf, o1); o2 = MFMA32(v2, pf, o2); o3 = MFMA32(v3, pf, o3); }
    }
    const float l = lrun + shx(lrun, lane, 32), inv = 1.f / l;
    const size_t tl = tokq;
    bf16_t* op = OG + ((size_t)g * TCH + tl) * 512 + (hh & 3) * 128 + 4 * h;
#pragma unroll
    for (int g4 = 0; g4 < 4; ++g4) {
        u32x2 w; w.x = cvtpk(o0[4 * g4] * inv, o0[4 * g4 + 1] * inv); w.y = cvtpk(o0[4 * g4 + 2] * inv, o0[4 * g4 + 3] * inv); *(u32x2*)(op + 8 * g4) = w;
        w.x = cvtpk(o1[4 * g4] * inv, o1[4 * g4 + 1] * inv); w.y = cvtpk(o1[4 * g4 + 2] * inv, o1[4 * g4 + 3] * inv); *(u32x2*)(op + 32 + 8 * g4) = w;
        w.x = cvtpk(o2[4 * g4] * inv, o2[4 * g4 + 1] * inv); w.y = cvtpk(o2[4 * g4 + 2] * inv, o2[4 * g4 + 3] * inv); *(u32x2*)(op + 64 + 8 * g4) = w;
        w.x = cvtpk(o3[4 * g4] * inv, o3[4 * g4 + 1] * inv); w.y = cvtpk(o3[4 * g4 + 2] * inv, o3[4 * g4 + 3] * inv); *(u32x2*)(op + 96 + 8 * g4) = w; }
    if (h == 0) LSE[((size_t)g * TCH + tl) * 4 + (hh & 3)] = mrun + __builtin_amdgcn_logf(l);
}

constexpr int DL_KP = 272, DL_VP = 776;
DI void dil_phase(unsigned char* lds, unsigned char* ws, int S, int sshift, int vcu, int G, int tid, int wave, int lane) {
    const bf16_t* QD = (const bf16_t*)(ws + WS_QD); const bf16_t* KD = (const bf16_t*)(ws + WS_KD); const bf16_t* VDT = (const bf16_t*)(ws + WS_VDT); bf16_t* OG = (bf16_t*)(ws + WS_OG); float* LSE = (float*)(ws + WS_LSE);
    const int r = lane & 31, h = lane >> 5;
    const int nunits = (TCH >> 8) * 12, upt = S >> 8;
    u32x4 st[12];
#define DL_DECODE(u) const int t256_ = (u) & (upt - 1), sh_ = (u) >> (sshift - 8), hh = sh_ % 12, seq = sh_ / 12, g = hh >> 2, ds = 2 * g, L = S >> ds, tsh_ = sshift - ds - 8, res = t256_ >> tsh_, m0 = (t256_ & ((1 << tsh_) - 1)) << 8
    const int kr_ = tid >> 4, kc_ = tid & 15, vr_ = tid >> 2, vq_ = tid & 3;
    unsigned char* const kst_ = lds + kr_ * DL_KP + kc_ * 16; (void)vr_; (void)vq_;
#define DL_KLOAD(u) do { DL_DECODE(u); const bf16_t* kg_ = KD + ((size_t)seq * S + res) * 1536 + hh * 128 + kc_ * 8; _Pragma("unroll") for (int i = 0; i < 12; ++i) { int m_ = m0 - 64 + kr_ + 32 * i; m_ = m_ < 0 ? 0 : (m_ >= L ? L - 1 : m_); \
        st[i] = *(const u32x4*)(kg_ + ((size_t)m_ << ds) * 1536); } } while (0)
#define DL_KSTORE() do { _Pragma("unroll") for (int i = 0; i < 12; ++i) *(u32x4*)(kst_ + i * (32 * DL_KP)) = st[i]; } while (0)
#define DL_VLOAD(u) do { DL_DECODE(u); const bf16_t* vg_ = VDT + ((size_t)seq * S + res) * 1536 + hh * 128 + kc_ * 8; _Pragma("unroll") for (int i = 0; i < 12; ++i) { int m_ = m0 - 64 + kr_ + 32 * i; m_ = m_ < 0 ? 0 : (m_ >= L ? L - 1 : m_); \
        st[i] = *(const u32x4*)(vg_ + ((size_t)m_ << ds) * 1536); } } while (0)
#define DL_VSTORE() do { _Pragma("unroll") for (int i = 0; i < 12; ++i) *(u32x4*)(vsw_ + i * (32 * 256)) = st[i]; } while (0)
    unsigned char* const vsw_ = lds + kr_ * 256 + ((kc_ ^ ((kr_ & 3) << 2)) << 4);
    typedef short v4i16_t __attribute__((ext_vector_type(4)));
    LASQ unsigned char* const l3_ = (LASQ unsigned char*)lds;
    const int i16_ = lane & 15, tq_ = i16_ >> 2, tp_ = i16_ & 3, tblk_ = (lane >> 4) & 1;
    int u = vcu;
    if (u < nunits) { DL_KLOAD(u); DL_KSTORE(); }
    __syncthreads();
    for (; u < nunits; u += G) {
        DL_DECODE(u);
        DL_VLOAD(u);
        const int mq0 = m0 + 32 * wave;
        const size_t tokq = (size_t)seq * S + ((size_t)(mq0 + r) << ds) + res;
        const bf16_t* qp = QD + tokq * 1536 + hh * 128 + 8 * h;
        bf16x8 qf[8];
#pragma unroll
        for (int s = 0; s < 8; ++s) qf[s] = *(const bf16x8*)(qp + 16 * s);
        f32x16 sc[5]; float mx = -1e30f;
#pragma unroll
        for (int j = 0; j < 5; ++j) {
            const int mk0 = mq0 - 64 + 32 * j;
            sc[j] = zero16();
            if (mk0 >= 0 && mk0 < L) {
                const unsigned char* kb = lds + (32 * wave + 32 * j + r) * DL_KP + 16 * h;
                bf16x8 kf[4];
#pragma unroll
                for (int s = 0; s < 4; ++s) kf[s] = *(const bf16x8*)(kb + 32 * s);
#pragma unroll
                for (int s = 0; s < 4; ++s) sc[j] = MFMA32(kf[s], qf[s], sc[j]);
#pragma unroll
                for (int s = 0; s < 4; ++s) kf[s] = *(const bf16x8*)(kb + 128 + 32 * s);
#pragma unroll
                for (int s = 0; s < 4; ++s) sc[j] = MFMA32(kf[s], qf[4 + s], sc[j]);
                if (j == 0 || j == 4) {
#pragma unroll
                    for (int i = 0; i < 16; ++i) { const int kr = (i & 3) + 8 * (i >> 2) + 4 * h; const bool ok = (j == 0) ? (kr >= r) : (kr <= r); sc[j][i] = ok ? sc[j][i] : -1e30f; }
                }
                mx = fmaxf(mx, vmax16(sc[j]));
            } else {
#pragma unroll
                for (int i = 0; i < 16; ++i) sc[j][i] = -1e30f;
            }
        }
        mx = fmaxf(mx, shx(mx, lane, 32));
        float lsum = 0.f;
#pragma unroll
        for (int j = 0; j < 5; ++j) lsum += exp_sum16(sc[j], mx);
        lsum += shx(lsum, lane, 32);
        bf16x8 pfr[5][2];
#pragma unroll
        for (int j = 0; j < 5; ++j) { pfr[j][0] = packp(sc[j], 0); pfr[j][1] = packp(sc[j], 1); }
        __syncthreads();
        DL_VSTORE();
        __syncthreads();
        const int un = u + G;
        if (un < nunits) DL_KLOAD(un);
        f32x16 o0 = zero16(), o1 = zero16(), o2 = zero16(), o3 = zero16();
#pragma unroll
        for (int j = 0; j < 5; ++j) {
            const int mk0 = mq0 - 64 + 32 * j;
            if (mk0 >= 0 && mk0 < L) {
#pragma unroll
                for (int s2 = 0; s2 < 2; ++s2) { const bf16x8 pf = pfr[j][s2];
                    const int row_ = 32 * wave + 32 * j + 16 * s2 + 4 * h + tq_;
                    const int rb_ = row_ * 256 + (tp_ & 1) * 8, pc_ = 2 * tblk_ + (tp_ >> 1), sw_ = tq_ << 2;
#define DL_TR(dvb, hi) __builtin_bit_cast(s16x4, __builtin_amdgcn_ds_read_tr16_b64_v4i16((LASQ v4i16_t*)(l3_ + rb_ + (hi) * (8 * 256) + (((4 * (dvb) + pc_) ^ sw_) << 4))))
                    const bf16x8 v0 = cat44(DL_TR(0, 0), DL_TR(0, 1)); const bf16x8 v1 = cat44(DL_TR(1, 0), DL_TR(1, 1));
                    const bf16x8 v2 = cat44(DL_TR(2, 0), DL_TR(2, 1)); const bf16x8 v3 = cat44(DL_TR(3, 0), DL_TR(3, 1));
#undef DL_TR
                    o0 = MFMA32(v0, pf, o0); o1 = MFMA32(v1, pf, o1); o2 = MFMA32(v2, pf, o2); o3 = MFMA32(v3, pf, o3); }
            }
        }
        const float inv = 1.f / lsum;
        bf16_t* op = OG + ((size_t)g * TCH + tokq) * 512 + (hh & 3) * 128 + 4 * h;
#pragma unroll
        for (int g4 = 0; g4 < 4; ++g4) {
            u32x2 w; w.x = cvtpk(o0[4 * g4] * inv, o0[4 * g4 + 1] * inv); w.y = cvtpk(o0[4 * g4 + 2] * inv, o0[4 * g4 + 3] * inv); *(u32x2*)(op + 8 * g4) = w;
            w.x = cvtpk(o1[4 * g4] * inv, o1[4 * g4 + 1] * inv); w.y = cvtpk(o1[4 * g4 + 2] * inv, o1[4 * g4 + 3] * inv); *(u32x2*)(op + 32 + 8 * g4) = w;
            w.x = cvtpk(o2[4 * g4] * inv, o2[4 * g4 + 1] * inv); w.y = cvtpk(o2[4 * g4 + 2] * inv, o2[4 * g4 + 3] * inv); *(u32x2*)(op + 64 + 8 * g4) = w;
            w.x = cvtpk(o3[4 * g4] * inv, o3[4 * g4 + 1] * inv); w.y = cvtpk(o3[4 * g4 + 2] * inv, o3[4 * g4 + 3] * inv); *(u32x2*)(op + 96 + 8 * g4) = w; }
        if (h == 0) LSE[((size_t)g * TCH + tokq) * 4 + (hh & 3)] = mx + __builtin_amdgcn_logf(lsum);
        __syncthreads();
        if (un < nunits) DL_KSTORE();
        __syncthreads();
    }
#undef DL_DECODE
#undef DL_KLOAD
#undef DL_KSTORE
#undef DL_VLOAD
#undef DL_VSTORE
}

constexpr int LDS_MISC = 131072, LDS_RSTD = 131072 + 64, LDS_RSTD_ROWS = 2048, LDS_BYTES = LDS_RSTD + LDS_RSTD_ROWS * 4;
constexpr int NPHASE = 1 + (NCHUNK - 1) + NCHUNK * NLAYER * 7 + 1;
struct Args { const float* in[19]; float* out; unsigned char* ws; int ph_lo, ph_hi; };


#define XB_TMO      128
#define XB_XCNT(j)  (256  + 64 * (j))
#define XB_XSUB(j)  (1280 + 64 * (j))
#define XB_XGEN(j)  (2304 + 64 * (j))
#define XB_TOP      3328
#define XB_TOPGEN   3392
#define XCD_BAR_WORDS 3456
#define XB_SPIN_CAP (1u << 20)
DI unsigned xb_ld(unsigned* p)              { return __hip_atomic_load(p, __ATOMIC_RELAXED, __HIP_MEMORY_SCOPE_AGENT); }
DI unsigned xb_add(unsigned* p, unsigned v) { return __hip_atomic_fetch_add(p, v, __ATOMIC_RELAXED, __HIP_MEMORY_SCOPE_AGENT); }
DI unsigned xb_xcc_id() { return (unsigned)__builtin_amdgcn_s_getreg((3 << 11) | 20) & 0xFu; }
#define XB_SPIN(cond, bar) do { unsigned _sp = 0; while (cond) { __builtin_amdgcn_s_sleep(1); \
    if ((++_sp & 255u) == 0u) { if (xb_ld(&(bar)[XB_TMO])) break; if (_sp > XB_SPIN_CAP) { atomicAdd(&(bar)[XB_TMO], 1u); break; } } } } while (0)
DI void xcd_barrier_complete(unsigned* bar, unsigned x, unsigned& nloc, unsigned& nx) {
    const unsigned G = gridDim.x * gridDim.y * gridDim.z;
    unsigned sum, cnt, mine, sp = 0u;
    for (;;) {
        sum = 0u; cnt = 0u; mine = 0u;
#pragma unroll
        for (unsigned j = 0; j < 16; ++j) { const unsigned c = xb_ld(&bar[XB_XCNT(j)]); sum += c; cnt += (c > 0u) ? 1u : 0u; mine = (j == x) ? c : mine; }
        if (sum == G) break;
        __builtin_amdgcn_s_sleep(1);
        if ((++sp & 255u) == 0u) { if (xb_ld(&bar[XB_TMO])) break; if (sp > XB_SPIN_CAP) { atomicAdd(&bar[XB_TMO], 1u); break; } }
    }
    nloc = mine > 0u ? mine : 1u; nx = cnt > 0u ? cnt : 1u;
}
DI void xcd_barrier(unsigned* bar, volatile LASQ unsigned* st, const bool leader) {
    asm volatile("s_waitcnt vmcnt(0)" ::: "memory");
    __syncthreads();
    if (leader) {
        const unsigned x = xb_xcc_id();
        __builtin_amdgcn_s_waitcnt(0);
        unsigned nloc = st[0], nx = st[1];
        if (nloc == 0u) { xcd_barrier_complete(bar, x, nloc, nx); st[0] = nloc; st[1] = nx; }
        const unsigned old = xb_add(&bar[XB_XSUB(x)], 1u);
        const unsigned gen = old / nloc;
        if (old + 1u == (gen + 1u) * nloc) {
            __builtin_amdgcn_fence(__ATOMIC_RELEASE, "agent");
            asm volatile("s_waitcnt vmcnt(0)" ::: "memory");
            const unsigned og = xb_add(&bar[XB_TOP], 1u);
            const unsigned tg = og / nx;
            if (og + 1u == (tg + 1u) * nx) xb_add(&bar[XB_TOPGEN], 1u);
            else XB_SPIN(xb_ld(&bar[XB_TOPGEN]) == tg, bar);
            __builtin_amdgcn_fence(__ATOMIC_ACQUIRE, "agent");
            xb_add(&bar[XB_XGEN(x)], 1u);
            asm volatile("s_waitcnt vmcnt(0)" ::: "memory");
        } else {
            XB_SPIN(xb_ld(&bar[XB_XGEN(x)]) == gen, bar);
            __builtin_amdgcn_fence(__ATOMIC_ACQUIRE, "agent");
            asm volatile("s_waitcnt vmcnt(0)" ::: "memory");
        }
    }
    __syncthreads();
}

struct EpiP { int S, sshift, flag; unsigned char* ws; const float* xin; float* xout; };
template <int MODE> DI void run_gemm(unsigned char* lds, const bf16_t* A, int lda, const bf16_t* Bt, int N, int K, int G, int c, const EpiP& P, const int tid) {
    int tid_l = tid; asm volatile("" : "+v"(tid_l)); asm volatile("" : "+s"(K), "+s"(lda), "+s"(N));
    pg8::Gemm g{A, Bt, TCH, N, K, lda}; pg8::StaticOrder S; S.init(TCH, N, G, c, MODE == pg8::EM_INPROJ ? WGM_IN : (MODE == pg8::EM_FF1 ? WGM_FF : 4));
    pg8::EpiAll<MODE> E; E.S = P.S; E.sshift = P.sshift; E.flag = P.flag; E.ws = P.ws; E.xin = P.xin; E.xout = P.xout;
    E.rs_lds = (const LASQ float*)(lds + LDS_RSTD); E.rs_base = 0; E.rs_on = 0;
    if constexpr (MODE == pg8::EM_INPROJ || MODE == pg8::EM_Q || MODE == pg8::EM_K || MODE == pg8::EM_FF1) {
        int pmin = 1 << 30, pmax = -1; { pg8::Unit u_; for (int i = 0; S.next(i, u_); ++i) { pmin = u_.pm < pmin ? u_.pm : pmin; pmax = u_.pm > pmax ? u_.pm : pmax; } }
        const int nrow = pmax >= pmin ? (pmax - pmin + 1) * 256 : 0;
        if (nrow > 0 && nrow <= LDS_RSTD_ROWS) {
            const sq_t* sq = (const sq_t*)(P.ws + WS_STAT) + (MODE == pg8::EM_INPROJ ? 0 : (MODE == pg8::EM_FF1 ? TCH : (MODE == pg8::EM_Q ? 2 * TCH : 3 * TCH)));
            const float invn = MODE == pg8::EM_Q ? 1.f / 384.f : (MODE == pg8::EM_K ? 1.f / 256.f : 1.f / 1024.f);
            LASQ float* rl = (LASQ float*)(lds + LDS_RSTD);
            for (int r_ = tid_l; r_ < nrow; r_ += 512) rl[r_] = 1.f / sqrtf((float)sq[pmin * 256 + r_] * (invn * (1.f / 16777216.f)) + RMS_EPS);
            __syncthreads();
            E.rs_base = pmin * 256; E.rs_on = 1;
        }
    }
    pg8::gemm_phase<pg8::EpiAll<MODE>, pg8::StaticOrder, true, true>((PG8_LAS unsigned char*)lds, g, S, E, tid_l);
}

__global__ void __launch_bounds__(512, 2) fwd_megakernel(Args a) {
    extern __shared__ __attribute__((aligned(16))) unsigned char lds[];
    cg::grid_group grid = cg::this_grid();
    const int G = gridDim.x, bx = blockIdx.x, NGW = G * 8, NGT = G * 512;
    const int vcu = (G % 8 == 0) ? (bx % 8) * (G / 8) + bx / 8 : bx;
    const int lo = a.ph_lo, hi = a.ph_hi; int ph = 0, c = 0, l = 0;
    const int wave0 = __builtin_amdgcn_readfirstlane((int)threadIdx.x >> 6);
    volatile LASQ unsigned* bar_st = (volatile LASQ unsigned*)((LASQ unsigned char*)lds + LDS_MISC);
    if (threadIdx.x < 16) bar_st[threadIdx.x] = 0u;
    __syncthreads();
    if (threadIdx.x == 0) (void)xb_add((unsigned*)(a.ws + WS_BAR) + XB_XCNT(xb_xcc_id()), 1u);
    typedef const __attribute__((address_space(4))) Args* KArgP;
#define PH_BEGIN if (ph >= lo && ph < hi) { const int lane = fresh_lane(); int wave_ = wave0; asm volatile("" : "+s"(wave_)); const int wave = wave_, tid = wave_ * 64 + lane; int c_ = c, l_ = l; asm volatile("" : "+s"(c_), "+s"(l_)); \
        KArgP ap = (KArgP)__builtin_amdgcn_kernarg_segment_ptr(); asm volatile("" : "+s"(ap)); \
        const int gw = vcu * 8 + wave, gtid = bx * 512 + tid; (void)lane; (void)gw; (void)gtid; \
        unsigned char* ws = ap->ws; const int S = c_ < 4 ? 4096 : 8192, sshift = c_ < 4 ? 12 : 13; (void)sshift; \
        const float* xin = c_ < 4 ? ap->in[0] + (size_t)c_ * TCH * 1024 : ap->in[1]; float* xo = ap->out + (size_t)c_ * TCH * 1024; \
        unsigned char* wl = ws + (size_t)l_ * W_LAYER; (void)wl; const float* xcur = l_ == 0 ? xin : xo; \
        sq_t* SQ = (sq_t*)(ws + WS_STAT); (void)SQ; EpiP E; E.S = S; E.sshift = sshift; E.flag = 0; E.ws = ws; E.xin = xcur; E.xout = xo;
#define PH_END } ++ph; if (ph > lo && ph < hi) { if (ph == 1) grid.sync(); else { xcd_barrier((unsigned*)(a.ws + WS_BAR), bar_st, wave0 == 0 && fresh_lane() == 0); if (PROBE == 10) xcd_barrier((unsigned*)(a.ws + WS_BAR), bar_st, wave0 == 0 && fresh_lane() == 0); } }

    PH_BEGIN
        for (int rep_ = 0; rep_ < (PROBE == 11 ? 2 : 1); ++rep_) {
#pragma nounroll
        for (int ll = 0; ll < NLAYER; ++ll) { unsigned char* wq = ws + (size_t)ll * W_LAYER;
            conv_items<1>(ap->in[3] + (size_t)ll * 1024 * INW, 1024, INW, (bf16_t*)(wq + W_IN), INP, gtid, NGT, 0, 0, ap->in[2] + ll * 1024);
            conv_items<0>(ap->in[16] + (size_t)ll * 1024 * 4096, 1024, 4096, (bf16_t*)(wq + W_FF1), 4096, gtid, NGT, 0, 0, ap->in[15] + ll * 1024);
            conv_items<0>(ap->in[17] + (size_t)ll * 4096 * 1024, 4096, 1024, (bf16_t*)(wq + W_FF2), 1024, gtid, NGT);
            conv_items<0>(ap->in[14] + (size_t)ll * 1024 * 1024, 1024, 1024, (bf16_t*)(wq + W_O), 1024, gtid, NGT);
            conv_items<0>(ap->in[12] + (size_t)ll * 512 * 1024, 512, 1024, (bf16_t*)(wq + W_A), 1024, gtid, NGT, 1536, 512);
            conv_items<0>(ap->in[13] + (size_t)ll * 512 * 1024, 512, 1024, (bf16_t*)(wq + W_A), 1024, gtid, NGT, 1536, 1024);
            conv_items<2>(ap->in[8] + (size_t)ll * 384 * 768, 384, 768, (bf16_t*)(wq + W_UQ), 768, gtid, NGT, 0, 0, ap->in[6] + ll * 384);
            conv_items<0>(ap->in[9] + (size_t)ll * 256 * 512, 256, 512, (bf16_t*)(wq + W_UK), 512, gtid, NGT, 0, 0, ap->in[7] + ll * 256);
            conv_items<0>(ap->in[10] + (size_t)ll * 256 * 512, 256, 512, (bf16_t*)(wq + W_UV), 512, gtid, NGT, 0, 0, ap->in[7] + ll * 256);
            conv_weff(ap->in[4] + (size_t)ll * 4 * 128 * 128, ap->in[5] + (size_t)ll * 512, ap->in[11] + (size_t)ll * 512 * 1024, (bf16_t*)(wq + W_A), gtid, NGT); }
        rope_table((float*)(ws + WS_CS128), 64, 0.8659643233600653, gtid, NGT);
        rope_table((float*)(ws + WS_CS32), 16, 0.5623413251903491, gtid, NGT); }
        p0_rows(ap->in[0], (bf16_t*)(ws + WS_H), SQ, TCH, gw, NGW, lane);
        zero_sq(SQ + 2 * TCH, 2 * TCH, gtid, NGT);
    PH_END

#pragma nounroll
    for (c = 0; c < NCHUNK; ++c) {
#pragma nounroll
        for (l = 0; l < NLAYER; ++l) {
            if (l == 0 && c > 0) {
            PH_BEGIN
                final_rows((const bf16_t*)(ws + WS_MRG), SQ + 4 * TCH, ap->in[18], ap->out + (size_t)(c_ - 1) * TCH * 1024, TCH, gw, NGW, lane);
                p0_rows(xin, (bf16_t*)(ws + WS_H), SQ, TCH, gw, NGW, lane);
                zero_sq(SQ + 2 * TCH, 2 * TCH, gtid, NGT);
            PH_END
            }
            PH_BEGIN zero_sq(SQ + TCH, TCH, gtid, NGT);
                if (STAGGER && (bx & 8)) { for (int q_ = 0; q_ < STAGGER; ++q_) __builtin_amdgcn_s_sleep(127); }
                for (int rep_ = 0; rep_ < (PROBE == 1 ? 2 : 1); ++rep_) run_gemm<pg8::EM_INPROJ>(lds, (const bf16_t*)(ws + WS_H), 1024, (const bf16_t*)(wl + W_IN), INP, 1024, G, bx, E, tid); PH_END
            PH_BEGIN
                zero_sq(l_ == 0 ? SQ : SQ + 4 * TCH, TCH, gtid, NGT);
                pool_rows(ws, S, gw, NGW, lane);
#ifndef NO_DIL
                for (int rep_ = 0; rep_ < (PROBE == 2 ? 2 : 1); ++rep_) dil_phase(lds, ws, S, sshift, vcu, G, tid, wave, lane);
#endif
                const int rotk = G >= 192 ? (bx >= 192 ? bx - 192 : bx + G - 192) : bx;
                run_gemm<pg8::EM_Q>(lds, (const bf16_t*)(ws + WS_CQ), 768, (const bf16_t*)(wl + W_UQ), 768, 384, G, bx, E, tid);
                run_gemm<pg8::EM_K>(lds, (const bf16_t*)(ws + WS_CQ) + 384, 768, (const bf16_t*)(wl + W_UK), 1024, 256, G, rotk, E, tid);
            PH_END
            PH_BEGIN
                zero_sq(SQ + 2 * TCH, 2 * TCH, gtid, NGT);
                t2_rows(ws, gw, NGW, lane);
#ifndef NO_MLA
                { const int nqb = S >> 8, nunits = (TCH >> 8) * 8;
                  for (int rep_ = 0; rep_ < (PROBE == 4 ? 2 : 1); ++rep_) for (int u = vcu; u < nunits; u += G) { const int qb = u & (nqb - 1), hs = u >> (sshift - 8), head = hs & 7, seq = hs >> 3; if (tid == 0) bar_st[4] = 0u;
                      const bool bad = mla_unit<true>(lds, ws, seq, head, qb, S, tid, wave, lane); if (bad) bar_st[4] = 1u; __syncthreads(); const unsigned redo = bar_st[4]; __syncthreads();
                      if (redo) (void)mla_unit<false>(lds, ws, seq, head, qb, S, tid, wave, lane); } }
#endif
            PH_END
            PH_BEGIN
                for (int rep_ = 0; rep_ < (PROBE == 13 ? 2 : 1); ++rep_) run_gemm<pg8::EM_MRG>(lds, (const bf16_t*)(ws + WS_BR), 1536, (const bf16_t*)(wl + W_A), 1024, 1536, G, bx, E, tid);
            PH_END
            PH_BEGIN
                run_gemm<pg8::EM_WO>(lds, (const bf16_t*)(ws + WS_MRG), 1024, (const bf16_t*)(wl + W_O), 1024, 1024, G, bx, E, tid); PH_END
            PH_BEGIN for (int rep_ = 0; rep_ < (PROBE == 8 ? 2 : 1); ++rep_) run_gemm<pg8::EM_FF1>(lds, (const bf16_t*)(ws + WS_H), 1024, (const bf16_t*)(wl + W_FF1), 4096, 1024, G, bx, E, tid); PH_END
            PH_BEGIN E.flag = (l_ == NLAYER - 1);
                run_gemm<pg8::EM_FF2>(lds, (const bf16_t*)(ws + WS_FF), 4096, (const bf16_t*)(wl + W_FF2), 1024, 4096, G, bx, E, tid); PH_END
        }
    }
    c = NCHUNK - 1; l = 0;
    PH_BEGIN final_rows((const bf16_t*)(ws + WS_MRG), SQ + 4 * TCH, ap->in[18], ap->out + (size_t)(NCHUNK - 1) * TCH * 1024, TCH, gw, NGW, lane); PH_END
#undef PH_BEGIN
#undef PH_END
}

extern "C" void kernel_launch(void* const* d_in, const int* in_sizes, int n_in, void* d_out, int out_size, void* d_ws, size_t ws_size, hipStream_t stream) {
    static int grid = 0;
    if (grid == 0) {
        if (n_in != 19 || ws_size < WS_END || out_size != NCHUNK * TCH * 1024) { fprintf(stderr, "kernel_launch: unexpected shapes (n_in %d, out %d, ws %zu)\n", n_in, out_size, ws_size); grid = -1; return; }
        int dev = 0, cus = 0, per_cu = 0;
        if (hipGetDevice(&dev) != hipSuccess || hipDeviceGetAttribute(&cus, hipDeviceAttributeMultiprocessorCount, dev) != hipSuccess) { grid = -1; return; }
        if (hipFuncSetAttribute((const void*)fwd_megakernel, hipFuncAttributeMaxDynamicSharedMemorySize, LDS_BYTES) != hipSuccess) { fprintf(stderr, "kernel_launch: hipFuncSetAttribute failed\n"); grid = -1; return; }
        if (hipOccupancyMaxActiveBlocksPerMultiprocessor(&per_cu, (const void*)fwd_megakernel, 512, LDS_BYTES) != hipSuccess || per_cu < 1) { fprintf(stderr, "kernel_launch: occupancy query says %d\n", per_cu); per_cu = 1; }
        (void)hipGetLastError();
        grid = cus * 1;
    }
    if (grid < 0) return;
    if (hipMemsetAsync((char*)d_ws + WS_BAR, 0, XCD_BAR_WORDS * 4, stream) != hipSuccess) { fprintf(stderr, "kernel_launch: memset failed\n"); return; }
    Args a{};
    for (int i = 0; i < 19; ++i) a.in[i] = (const float*)d_in[i];
    a.out = (float*)d_out; a.ws = (unsigned char*)d_ws;
#if COOP
    a.ph_lo = 0; a.ph_hi = NPHASE;
    void* args[] = {&a};
    hipError_t e = hipLaunchCooperativeKernel((const void*)fwd_megakernel, dim3(grid), dim3(512), args, LDS_BYTES, stream);
    if (e != hipSuccess) fprintf(stderr, "cooperative launch failed: %s (grid %d)\n", hipGetErrorString(e), grid);
#else
    for (int p = 0; p < NPHASE; ++p) { a.ph_lo = p; a.ph_hi = p + 1; hipLaunchKernelGGL(fwd_megakernel, dim3(grid), dim3(512), LDS_BYTES, stream, a); }
#endif
}
```
